# Optimizing an MI355X kernel written in HIP

```python
import math
import jax, jax.numpy as jnp
from jax import lax
import numpy as np

D_MODEL = 1024
BATCH = 16
SEQ = 2048
DEPTH = 1

GRID_W = 64
CTX_LEN = 256
EPS = 1e-6
N_MOD = 9
D_FF = 2816
HEAD_DIM = 64
N_Q_HEADS = 8
N_KV_HEADS = 2
GROUP = N_Q_HEADS // N_KV_HEADS
ATT_WIDTH = N_Q_HEADS * HEAD_DIM
KV_WIDTH = N_KV_HEADS * HEAD_DIM
Q_BLOCK = 128
ROPE_THETA = 10000.0
ROPE_PAIRS = HEAD_DIM // 4
ATT_SCALE = HEAD_DIM ** -0.5
HG_HEADS = 4
HG_DK = 128
HG_DV = 128
HG_WIDTH = HG_HEADS * HG_DK
HG_VWIDTH = HG_HEADS * HG_DV
HG_SCALE = HG_DK ** -0.5
CHUNK = 64
IN_SPLITS = (ATT_WIDTH, KV_WIDTH, KV_WIDTH, HG_WIDTH, HG_VWIDTH, HG_WIDTH, HG_WIDTH, HG_VWIDTH, D_MODEL, D_MODEL)
D_IN = sum(IN_SPLITS)

kernel_name = "hybrid_gqa_hgrn2_macaron_prefix_block"


def rms_norm(x, gain):
    xf = x.astype(jnp.float32)
    y = xf * lax.rsqrt(jnp.mean(xf * xf, axis=-1, keepdims=True) + EPS)
    return (y * gain.astype(jnp.float32)).astype(x.dtype)


def modulation(cvec, w_mod_l, b_mod_l):
    m = jax.nn.silu(cvec) @ w_mod_l + b_mod_l
    return jnp.split(m[:, None, :], N_MOD, axis=-1)


def pre(h, g_pre, shift, scale):
    return rms_norm(h, g_pre) * (1.0 + scale) + shift


def post(y, g_post, gate):
    return gate * rms_norm(y, g_post)


def swiglu(u, w_gate, w_up, w_down):
    return (jax.nn.silu(u @ w_gate) * (u @ w_up)) @ w_down


def heads(a, d):
    return a.reshape(*a.shape[:-1], -1, d)


def split_in(p):
    out, start = [], 0
    for size in IN_SPLITS:
        out.append(p[..., start:start + size])
        start += size
    return out


def axial_rope(rows):
    row = jnp.repeat(jnp.arange(rows, dtype=jnp.float32), GRID_W)
    col = jnp.tile(jnp.arange(GRID_W, dtype=jnp.float32), rows)
    inv_freq = ROPE_THETA ** (-jnp.arange(ROPE_PAIRS, dtype=jnp.float32) / ROPE_PAIRS)
    ang_r = row[:, None] * inv_freq
    ang_c = col[:, None] * inv_freq
    ang = jnp.concatenate([ang_r, ang_r, ang_c, ang_c], axis=-1)
    return jnp.cos(ang), jnp.sin(ang)


def apply_rope(x, cos, sin):
    xa = x.reshape(*x.shape[:-1], 2, 2, ROPE_PAIRS)
    rot = jnp.stack([-xa[..., 1, :], xa[..., 0, :]], axis=-2).reshape(x.shape)
    return x * cos[:, None, :].astype(x.dtype) + rot * sin[:, None, :].astype(x.dtype)


def gqa_softmax(q, k, v):
    s = jnp.einsum('bqkgd,bskd->bkgqs', q, k).astype(jnp.float32) * ATT_SCALE
    p = jax.nn.softmax(s, axis=-1).astype(v.dtype)
    return jnp.einsum('bkgqs,bskd->bqkgd', p, v)


def latent_attention(q, k, v, k_ctx, v_ctx):
    bsz, t = q.shape[:2]
    k_all = jnp.concatenate([k, k_ctx], axis=1)
    v_all = jnp.concatenate([v, v_ctx], axis=1)
    nb = t // Q_BLOCK
    qb = jnp.moveaxis(q.reshape(bsz, nb, Q_BLOCK, N_KV_HEADS, GROUP, HEAD_DIM), 1, 0)
    o = lax.map(lambda qi: gqa_softmax(qi, k_all, v_all), qb)
    return jnp.moveaxis(o, 0, 1).reshape(bsz, t, ATT_WIDTH)


def att_kv(p, k_gain, cos=None, sin=None):
    k = rms_norm(heads(p[1], HEAD_DIM), k_gain)
    if cos is not None:
        k = apply_rope(k, cos, sin)
    return k, heads(p[2], HEAD_DIM)


def att_q(p, q_gain, cos=None, sin=None):
    q = rms_norm(heads(p[0], HEAD_DIM), q_gain)
    if cos is not None:
        q = apply_rope(q, cos, sin)
    return q.reshape(*q.shape[:2], N_KV_HEADS, GROUP, HEAD_DIM)


def forget_gate(f_raw, lb):
    lbh = lb.reshape(HG_HEADS, HG_DK)
    f = lbh + (1.0 - lbh) * jax.nn.sigmoid(heads(f_raw, HG_DK).astype(jnp.float32))
    return 1.0 - f, jnp.log(f)


def chunk_states(k, v, g, s0):
    bsz, t, h, dk = k.shape
    n = t // CHUNK
    kc = k.reshape(bsz, n, CHUNK, h, dk)
    vc = v.reshape(bsz, n, CHUNK, h, -1)
    b = jnp.cumsum(g.reshape(bsz, n, CHUNK, h, dk), axis=2)
    b_last = b[:, :, -1]
    ds = jnp.einsum('bnshk,bnshv->bnhkv', kc * jnp.exp(b_last[:, :, None] - b), vc)

    def step(s, inp):
        ds_n, dec_n = inp
        return dec_n[..., None] * s + ds_n, s

    s_fin, s_prev = lax.scan(step, s0, (jnp.moveaxis(ds, 1, 0), jnp.moveaxis(jnp.exp(b_last), 1, 0)))
    return jnp.moveaxis(s_prev, 0, 1), s_fin, b


def chunk_output(q, k, v, b, s_prev):
    bsz, t, h, dk = q.shape
    n = t // CHUNK
    qc = q.reshape(bsz, n, CHUNK, h, dk)
    kc = k.reshape(bsz, n, CHUNK, h, dk)
    vc = v.reshape(bsz, n, CHUNK, h, -1)
    b_mid = b[:, :, CHUNK // 2 - 1:CHUNK // 2]
    s = jnp.einsum('bnchk,bnshk->bnhcs', qc * jnp.exp(b - b_mid), kc * jnp.exp(b_mid - b))
    s = jnp.where(jnp.tril(jnp.ones((CHUNK, CHUNK), dtype=bool)), s, 0.0)
    o = (jnp.einsum('bnhcs,bnshv->bnchv', s, vc)
         + jnp.einsum('bnchk,bnhkv->bnchv', qc * jnp.exp(b), s_prev))
    return o.reshape(bsz, t, h, -1)


def hgrn_direction(q_x, v_x, f_x, q_c, v_c, f_c, lb):
    k_x, g_x = forget_gate(f_x, lb)
    k_c, g_c = forget_gate(f_c, lb)
    s0 = jnp.zeros((v_c.shape[0], HG_HEADS, HG_DK, HG_DV), jnp.float32)
    sp_c, sf_c, b_c = chunk_states(k_c, v_c, g_c, s0)
    sp_x, _, b_x = chunk_states(k_x, v_x, g_x, sf_c)
    o_x = chunk_output(q_x, k_x, v_x, b_x, sp_x)
    o_c = chunk_output(q_c, k_c, v_c, b_c, sp_c) if q_c is not None else None
    return o_x, o_c


def hg_query(p):
    return jax.nn.silu(heads(p[3], HG_DK).astype(jnp.float32)) * HG_SCALE


def hg_out(o, g_raw, hg_gain, dtype):
    o = rms_norm(o, hg_gain) * jax.nn.silu(heads(g_raw, HG_DV).astype(jnp.float32))
    return o.reshape(*o.shape[:2], HG_VWIDTH).astype(dtype)


def rev(a):
    return jnp.flip(a, axis=1)


def hgrn_branch(px, pc, lb_l, hg_gain, with_ctx):
    q_x = hg_query(px)
    v_x = heads(px[4], HG_DV).astype(jnp.float32)
    v_c = heads(pc[4], HG_DV).astype(jnp.float32)
    q_c = hg_query(pc) if with_ctx else None
    of_x, of_c = hgrn_direction(q_x, v_x, px[5], q_c, v_c, pc[5], lb_l[0])
    ob_x, ob_c = hgrn_direction(rev(q_x), rev(v_x), rev(px[6]),
                                rev(q_c) if with_ctx else None, rev(v_c), rev(pc[6]), lb_l[1])
    o_x = hg_out(of_x + rev(ob_x), px[7], hg_gain, px[7].dtype)
    o_c = hg_out(of_c + rev(ob_c), pc[7], hg_gain, pc[7].dtype) if with_ctx else None
    return o_x, o_c


def merge(p, o_att, o_hg, w_att_out_l, w_hg_out_l, w_o_l):
    y = jax.nn.sigmoid(p[8]) * (o_att @ w_att_out_l) + jax.nn.sigmoid(p[9]) * (o_hg @ w_hg_out_l)
    return y @ w_o_l


def token_mixer(ux, uc, cos, sin, w_in_l, q_gain, k_gain, lb_l, hg_gain,
                w_att_out_l, w_hg_out_l, w_o_l, with_ctx):
    px = split_in(ux @ w_in_l)
    pc = split_in(uc @ w_in_l)
    k_x, v_x = att_kv(px, k_gain, cos, sin)
    k_c, v_c = att_kv(pc, k_gain)
    o_att_x = latent_attention(att_q(px, q_gain, cos, sin), k_x, v_x, k_c, v_c)
    o_hg_x, o_hg_c = hgrn_branch(px, pc, lb_l, hg_gain, with_ctx)
    y_x = merge(px, o_att_x, o_hg_x, w_att_out_l, w_hg_out_l, w_o_l)
    y_c = None
    if with_ctx:
        q_c = att_q(pc, q_gain)
        o_att_c = gqa_softmax(q_c, k_c, v_c).reshape(*uc.shape[:2], ATT_WIDTH)
        y_c = merge(pc, o_att_c, o_hg_c, w_att_out_l, w_hg_out_l, w_o_l)
    return y_x, y_c


def setup_inputs(seed: int = 0) -> dict:
    key = jax.random.key(seed)
    ks = jax.random.split(key, 20)
    nrm = lambda k, shape, s: jax.random.normal(k, shape, jnp.float32) * s
    gain = lambda k, shape: 1.0 + 0.02 * jax.random.normal(k, shape, jnp.float32)
    return {
        "x": nrm(ks[0], (BATCH, SEQ, D_MODEL), 1.0),
        "c": nrm(ks[1], (BATCH, D_MODEL), 1.0),
        "ctx": nrm(ks[2], (BATCH, CTX_LEN, D_MODEL), 1.0),
        "c_ctx": nrm(ks[3], (D_MODEL,), 1.0),
        "w_mod": nrm(ks[4], (DEPTH, D_MODEL, N_MOD * D_MODEL), 0.5 * D_MODEL ** -0.5),
        "b_mod": nrm(ks[5], (DEPTH, N_MOD * D_MODEL), 0.02),
        "norm_pre": gain(ks[6], (DEPTH, 3, D_MODEL)),
        "norm_post": gain(ks[7], (DEPTH, 3, D_MODEL)),
        "ffn_w_gate": nrm(ks[8], (DEPTH, 2, D_MODEL, D_FF), D_MODEL ** -0.5),
        "ffn_w_up": nrm(ks[9], (DEPTH, 2, D_MODEL, D_FF), D_MODEL ** -0.5),
        "ffn_w_down": nrm(ks[10], (DEPTH, 2, D_FF, D_MODEL), D_FF ** -0.5),
        "w_in": nrm(ks[11], (DEPTH, D_MODEL, D_IN), D_MODEL ** -0.5),
        "q_norm": gain(ks[12], (DEPTH, HEAD_DIM)),
        "k_norm": gain(ks[13], (DEPTH, HEAD_DIM)),
        "hg_lower_bound": nrm(ks[14], (2, DEPTH + 1, HG_WIDTH), 0.1),
        "hg_norm": gain(ks[15], (DEPTH, HG_DV)),
        "w_att_out": nrm(ks[16], (DEPTH, ATT_WIDTH, D_MODEL), ATT_WIDTH ** -0.5),
        "w_hg_out": nrm(ks[17], (DEPTH, HG_VWIDTH, D_MODEL), HG_VWIDTH ** -0.5),
        "w_o": nrm(ks[18], (DEPTH, D_MODEL, D_MODEL), D_MODEL ** -0.5),
    }


def reference(x, c, ctx, c_ctx, w_mod, b_mod, norm_pre, norm_post, ffn_w_gate, ffn_w_up, ffn_w_down,
              w_in, q_norm, k_norm, hg_lower_bound, hg_norm, w_att_out, w_hg_out, w_o):
    t = x.shape[1]
    rows = t // GRID_W
    cos, sin = axial_rope(rows)
    lb_all = jnp.cumsum(jax.nn.softmax(hg_lower_bound.astype(jnp.float32), axis=1), axis=1)
    h_c = ctx
    for l in range(DEPTH):
        last = l == DEPTH - 1
        mx = modulation(c, w_mod[l], b_mod[l])
        mc = modulation(c_ctx[None, :], w_mod[l], b_mod[l])
        ffn1 = lambda h, m: 0.5 * post(swiglu(pre(h, norm_pre[l, 0], m[0], m[1]), ffn_w_gate[l, 0],
                                              ffn_w_up[l, 0], ffn_w_down[l, 0]), norm_post[l, 0], m[2])
        x = x + ffn1(x, mx)
        h_c = h_c + ffn1(h_c, mc)
        ux = pre(x, norm_pre[l, 1], mx[3], mx[4])
        uc = pre(h_c, norm_pre[l, 1], mc[3], mc[4])
        y_x, y_c = token_mixer(ux, uc, cos, sin, w_in[l], q_norm[l], k_norm[l], lb_all[:, l], hg_norm[l],
                               w_att_out[l], w_hg_out[l], w_o[l], with_ctx=not last)
        x = x + post(y_x, norm_post[l, 1], mx[5])
        ffn2 = lambda h, m: 0.5 * post(swiglu(pre(h, norm_pre[l, 2], m[6], m[7]), ffn_w_gate[l, 1],
                                              ffn_w_up[l, 1], ffn_w_down[l, 1]), norm_post[l, 2], m[8])
        if not last:
            h_c = h_c + post(y_c, norm_post[l, 1], mc[5])
            h_c = h_c + ffn2(h_c, mc)
        x = x + ffn2(x, mx)
    return x
```

```cpp
#include <hip/hip_runtime.h>
#include <hip/hip_cooperative_groups.h>
#include <cstdio>
#include <cstdint>
namespace cg = cooperative_groups;
__device__ __forceinline__ int opaque_tid() { int t; asm volatile("v_mov_b32 %0, %1" : "=v"(t) : "v"((int)threadIdx.x)); return t; }
namespace pg8 {
#define PG8_LAS __attribute__((address_space(3)))
typedef unsigned short bf16_t;
typedef short bf16x8 __attribute__((ext_vector_type(8)));
typedef float f32x4 __attribute__((ext_vector_type(4)));
typedef unsigned u32x4 __attribute__((ext_vector_type(4)));
constexpr int BM = 256, BK = 64, HALF = 128, HTB = HALF * BK * 2  , STAGE_BYTES = 8 * HTB, NXCD = 8, WGM = 8;

__host__ __device__ __forceinline__ int lds_byte(int r, int c) { const int st = (r >> 4) * 2 + (c >> 5), rr = r & 15, cc = c & 31, ob = rr * 64 + cc * 2; return st * 1024 + (ob ^ (((ob >> 9) & 1) << 5)); }
__host__ __device__ __forceinline__ void stage_rc(int b, int& R, int& C) { const int st = b / 1024, sb = b % 1024, swz = sb ^ (((sb >> 9) & 1) << 5); R = (st >> 1) * 16 + swz / 64; C = (st & 1) * 32 + (swz % 64) / 2; }
__host__ __device__ __forceinline__ int perm32(int rho) { const int n = rho >> 4, i = rho & 15; return 8 * (i >> 2) + 4 * n + (i & 3); }

struct Unit { int pm, pn; };
struct Gemm { const bf16_t* A; const bf16_t* Bt; int M, N, K; };

struct StaticOrder {
    int nM, nN, nwg, G, c;
    __host__ __device__ void init(int M, int N, int G_, int c_) { nM = M / BM; nN = N / BM; nwg = nM * nN; G = G_; c = c_; }
    __host__ __device__ bool next(int i, Unit& u) const {
        const long L = (long)i * G + c; if (L >= nwg) return false;
        int wgid = (int)L; { const int q = nwg / NXCD, r = nwg % NXCD, xcd = wgid % NXCD, off = wgid / NXCD; wgid = (xcd < r ? xcd * (q + 1) : r * (q + 1) + (xcd - r) * q) + off; }
        const int nig = WGM * nN, gid = wgid / nig, fm = gid * WGM, gsz = (nM - fm) < WGM ? (nM - fm) : WGM;
        u.pm = fm + ((wgid % nig) % gsz); u.pn = (wgid % nig) / gsz; return true;
    }
    __device__ __forceinline__ void a_ready(const Unit&) const {}
    __device__ __forceinline__ void done(const Unit&) const {}
};

__device__ __forceinline__ unsigned cvt_pk_bf16(float lo, float hi) { unsigned r; asm volatile("v_cvt_pk_bf16_f32 %0, %1, %2" : "=v"(r) : "v"(lo), "v"(hi)); return r; }
template <class Epi, class Sched, bool ALIGN_EPI = false, bool SP2 = false>
__device__ __forceinline__ void gemm_phase(PG8_LAS unsigned char* lds, const Gemm g, const Sched& S, const Epi& E) {
    const int tid = opaque_tid(), wid = __builtin_amdgcn_readfirstlane(tid >> 6), lane = tid & 63, wr = wid >> 2, wc = wid & 3, fr = lane & 15, fq = lane >> 4;
    const int K = g.K, nt = K / BK;
    unsigned voffA[2], voffB[2];
#pragma unroll
    for (int i = 0; i < 2; ++i) { int R, C; stage_rc(tid * 16 + i * 8192, R, C); const int Rb = Epi::PERM ? ((R & ~31) + perm32(R & 31)) : R;
        voffA[i] = (unsigned)(R * K + C) * 2u; voffB[i] = (unsigned)(Rb * K + C) * 2u; }
    const size_t kstep = (size_t)(BK * 2);
    const size_t hstep = (size_t)HALF * K * 2;
    const size_t tstep = 2 * hstep;
    const unsigned ldsw = (unsigned)wid * 1024u;
    const int aoff = lds_byte(wr * 64 + fr, fq * 8), boff = lds_byte(wc * 32 + fr, fq * 8);
#define PG8_SA(b, h) (((b) * 2 + (h)) * HTB)
#define PG8_SB(b, h) ((4 + (b) * 2 + (h)) * HTB)
#define PG8_STAGE(bufoff, gbase, voff) do { _Pragma("unroll") for (int _i = 0; _i < 2; ++_i) \
        __builtin_amdgcn_global_load_lds((const unsigned*)((const char*)(gbase) + (voff)[_i]), (PG8_LAS unsigned*)(lds + (bufoff) + ldsw + _i * 8192), 16, 0, 0); } while (0)
#define PG8_LDA(dst, b, h) do { _Pragma("unroll") for (int m = 0; m < 4; ++m) _Pragma("unroll") for (int k = 0; k < 2; ++k) dst[m][k] = *(const PG8_LAS bf16x8*)(lds + PG8_SA(b, h) + aoff + m * 2048 + k * 1024); } while (0)
#define PG8_LDB(dst, b, h) do { _Pragma("unroll") for (int n = 0; n < 2; ++n) _Pragma("unroll") for (int k = 0; k < 2; ++k) dst[n][k] = *(const PG8_LAS bf16x8*)(lds + PG8_SB(b, h) + boff + n * 2048 + k * 1024); } while (0)
#define PG8_MMA(ai, bj, At, Bt) do { __builtin_amdgcn_s_setprio(1); _Pragma("unroll") for (int m = 0; m < 4; ++m) _Pragma("unroll") for (int n = 0; n < 2; ++n) _Pragma("unroll") for (int k = 0; k < 2; ++k) \
        acc[ai][bj][m][n] = __builtin_amdgcn_mfma_f32_16x16x32_bf16(Bt[n][k], At[m][k], acc[ai][bj][m][n], 0, 0, 0); __builtin_amdgcn_s_setprio(0); } while (0)
#define PG8_WAIT_V(n) asm volatile("s_waitcnt vmcnt(" #n ")" ::: "memory")
#define PG8_WAIT_L(n) asm volatile("s_waitcnt lgkmcnt(" #n ")" ::: "memory")
#define PG8_BAR __builtin_amdgcn_s_barrier()
#define PG8_SCHED __builtin_amdgcn_sched_barrier(0)
    Unit cur, nxt; int ui = 0;
    if (!S.next(0, cur)) return;
    f32x4 acc[2][2][4][2];
#pragma unroll
    for (int a = 0; a < 2; ++a)
#pragma unroll
        for (int b = 0; b < 2; ++b)
#pragma unroll
            for (int m = 0; m < 4; ++m)
#pragma unroll
                for (int n = 0; n < 2; ++n) acc[a][b][m][n] = (f32x4){0.f, 0.f, 0.f, 0.f};
    bf16x8 At[4][2], B0[2][2], B1[2][2];
    const char* cA = (const char*)g.A + (size_t)cur.pm * tstep; const char* cB = (const char*)g.Bt + (size_t)cur.pn * tstep;
    S.a_ready(cur);
    if constexpr (SP2) {
        PG8_STAGE(PG8_SB(0, 0), cB, voffB); PG8_STAGE(PG8_SB(0, 1), cB + hstep, voffB); PG8_STAGE(PG8_SA(0, 0), cA, voffA); PG8_STAGE(PG8_SA(0, 1), cA + hstep, voffA);
        if (wr == 1) PG8_BAR;
        PG8_WAIT_V(2); PG8_BAR;
        PG8_STAGE(PG8_SB(1, 0), cB + kstep, voffB); PG8_STAGE(PG8_SA(1, 0), cA + kstep, voffA); PG8_STAGE(PG8_SB(1, 1), cB + hstep + kstep, voffB);
        PG8_WAIT_V(6); PG8_BAR;
    } else {
        PG8_STAGE(PG8_SB(0, 0), cB, voffB); PG8_STAGE(PG8_SA(0, 0), cA, voffA); PG8_STAGE(PG8_SB(0, 1), cB + hstep, voffB); PG8_STAGE(PG8_SA(0, 1), cA + hstep, voffA);
        if (wr == 1) PG8_BAR;
        PG8_WAIT_V(4); PG8_BAR;
        PG8_STAGE(PG8_SB(1, 0), cB + kstep, voffB); PG8_STAGE(PG8_SA(1, 0), cA + kstep, voffA); PG8_STAGE(PG8_SB(1, 1), cB + hstep + kstep, voffB);
        PG8_WAIT_V(6); PG8_BAR;
    }
    for (;;) {
        const bool has_next = S.next(ui + 1, nxt);
        const char* nA = has_next ? (const char*)g.A + (size_t)nxt.pm * tstep : cA; const char* nB = has_next ? (const char*)g.Bt + (size_t)nxt.pn * tstep : cB;
        for (int t = 0; t < nt; t += 2) {
            const bool last = (t == nt - 2);
            if constexpr (Epi::HAS_MID) { if (t == (nt >> 1)) E.mid(acc, cur, wr, wc, fr, fq); }
            const char* a1 = cA + (size_t)(t + 1) * kstep;
            const char* a2 = last ? nA : cA + (size_t)(t + 2) * kstep; const char* b2 = last ? nB : cB + (size_t)(t + 2) * kstep;
            const char* a3 = a2 + kstep; const char* b3 = b2 + kstep;
            if (last && has_next) S.a_ready(nxt);
            if constexpr (SP2) {
            PG8_LDB(B0, 0, 0); PG8_LDB(B1, 0, 1); PG8_SCHED; PG8_LDA(At, 0, 0); PG8_STAGE(PG8_SA(1, 1), a1 + hstep, voffA);
            PG8_WAIT_V(8); PG8_WAIT_L(0); PG8_BAR; PG8_MMA(0, 0, At, B0); PG8_MMA(0, 1, At, B1); PG8_BAR; PG8_SCHED;
            PG8_LDA(At, 0, 1); PG8_STAGE(PG8_SB(0, 0), b2, voffB); PG8_STAGE(PG8_SB(0, 1), b2 + hstep, voffB); PG8_STAGE(PG8_SA(0, 0), a2, voffA);
            PG8_WAIT_V(8); PG8_WAIT_L(0); PG8_BAR; PG8_MMA(1, 0, At, B0); PG8_MMA(1, 1, At, B1); PG8_BAR; PG8_SCHED;
            PG8_LDB(B0, 1, 0); PG8_LDB(B1, 1, 1); PG8_SCHED; PG8_LDA(At, 1, 0); PG8_STAGE(PG8_SA(0, 1), a2 + hstep, voffA);
            PG8_WAIT_V(8); PG8_WAIT_L(0); PG8_BAR; PG8_MMA(0, 0, At, B0); PG8_MMA(0, 1, At, B1); PG8_BAR; PG8_SCHED;
            PG8_LDA(At, 1, 1); PG8_STAGE(PG8_SB(1, 0), b3, voffB); PG8_STAGE(PG8_SB(1, 1), b3 + hstep, voffB); PG8_STAGE(PG8_SA(1, 0), a3, voffA);
            PG8_WAIT_V(8); PG8_WAIT_L(0); PG8_BAR; PG8_MMA(1, 0, At, B0); PG8_MMA(1, 1, At, B1); PG8_BAR; PG8_SCHED;
            } else {
            PG8_LDB(B0, 0, 0); PG8_SCHED; PG8_LDA(At, 0, 0); PG8_STAGE(PG8_SA(1, 1), a1 + hstep, voffA);
            PG8_WAIT_L(8); PG8_BAR; PG8_WAIT_L(0); PG8_MMA(0, 0, At, B0); PG8_BAR; PG8_SCHED;
            PG8_LDB(B1, 0, 1); PG8_STAGE(PG8_SB(0, 0), b2, voffB);
            PG8_BAR; PG8_WAIT_L(0); PG8_MMA(0, 1, At, B1); PG8_BAR;
            PG8_LDA(At, 0, 1); PG8_STAGE(PG8_SA(0, 0), a2, voffA);
            PG8_BAR; PG8_WAIT_L(0); PG8_MMA(1, 0, At, B0); PG8_BAR; PG8_SCHED;
            PG8_STAGE(PG8_SB(0, 1), b2 + hstep, voffB);
            PG8_WAIT_V(6); PG8_BAR; PG8_MMA(1, 1, At, B1); PG8_BAR;
            PG8_LDB(B0, 1, 0); PG8_SCHED; PG8_LDA(At, 1, 0); PG8_STAGE(PG8_SA(0, 1), a2 + hstep, voffA);
            PG8_WAIT_L(8); PG8_BAR; PG8_WAIT_L(0); PG8_MMA(0, 0, At, B0); PG8_BAR; PG8_SCHED;
            PG8_LDB(B1, 1, 1); PG8_STAGE(PG8_SB(1, 0), b3, voffB);
            PG8_BAR; PG8_WAIT_L(0); PG8_MMA(0, 1, At, B1); PG8_BAR;
            PG8_LDA(At, 1, 1); PG8_STAGE(PG8_SA(1, 0), a3, voffA);
            PG8_BAR; PG8_WAIT_L(0); PG8_MMA(1, 0, At, B0); PG8_BAR; PG8_SCHED;
            PG8_STAGE(PG8_SB(1, 1), b3 + hstep, voffB);
            PG8_WAIT_V(6); PG8_BAR; PG8_MMA(1, 1, At, B1); PG8_BAR;
            }
        }
        if constexpr (ALIGN_EPI) { if (wr == 0) PG8_BAR; }
        if constexpr (!Epi::AFTER_DRAIN) { E(acc, cur, wr, wc, fr, fq); S.done(cur); }
        if (!has_next) break;
#pragma unroll
        for (int a = 0; a < 2; ++a)
#pragma unroll
            for (int b = 0; b < 2; ++b)
#pragma unroll
                for (int m = 0; m < 4; ++m)
#pragma unroll
                    for (int n = 0; n < 2; ++n) acc[a][b][m][n] = (f32x4){0.f, 0.f, 0.f, 0.f};
        cur = nxt; cA = nA; cB = nB; ++ui;
        if constexpr (ALIGN_EPI) { if (wr == 1) PG8_BAR; }
    }
    PG8_WAIT_V(0);
    if constexpr (!ALIGN_EPI) { if (wr == 0) PG8_BAR; }
    PG8_BAR;
    if constexpr (Epi::AFTER_DRAIN) { E.fused(acc, cur, wr, wc, fr, fq, lds, wid, lane); S.done(cur); }
#undef PG8_SA
#undef PG8_SB
#undef PG8_STAGE
#undef PG8_LDA
#undef PG8_LDB
#undef PG8_MMA
#undef PG8_WAIT_V
#undef PG8_WAIT_L
#undef PG8_BAR
#undef PG8_SCHED
}
}

#define LAS __attribute__((address_space(3)))
typedef unsigned short bf16_t;
typedef short bf16x8 __attribute__((ext_vector_type(8)));
typedef float f32x4 __attribute__((ext_vector_type(4)));
typedef float f32x16 __attribute__((ext_vector_type(16)));
typedef unsigned u32x4 __attribute__((ext_vector_type(4)));
typedef unsigned u32x2 __attribute__((ext_vector_type(2)));
using pg8::Unit;

constexpr int D = 1024, NB = 16, SEQ = 2048, CTXL = 256, TL = NB * SEQ, TC = NB * CTXL, TT = TL + TC, DFF = 2816, DIN = 5376, NMOD = 9;
constexpr int PW = 4608, PCW = 1536, NKEY = SEQ + CTXL;
constexpr float EPS = 1e-6f;
constexpr int NTHREADS = 512;
constexpr int LDS_BYTES = 131072 + 1024;
constexpr int MISC_OFF = 131072;

constexpr size_t MiB = 1048576;
constexpr size_t WS_MOD = 0;
constexpr size_t WS_LB = 768 * 1024;
constexpr size_t WS_ROPE = 800 * 1024;
constexpr size_t WS_CTL = 900 * 1024;
constexpr size_t WS_WIN = 1 * MiB;
constexpr size_t WS_WAO = WS_WIN + 11010048;
constexpr size_t WS_WHO = WS_WAO + 1 * MiB;
constexpr size_t WS_WO = WS_WHO + 1 * MiB;
constexpr size_t WS_FW = WS_WO + 2 * MiB;
constexpr size_t WS_U = 32 * MiB;
constexpr size_t WS_BIG = 104 * MiB;
constexpr size_t WS_Y = WS_BIG + 198 * MiB;
constexpr size_t WS_Q = 392 * MiB;
constexpr size_t WS_K = 424 * MiB;
constexpr size_t WS_VT = 433 * MiB;
constexpr size_t WS_OHF = 442 * MiB;
constexpr size_t WS_OHB = 474 * MiB;
constexpr size_t WS_END = 506 * MiB;
static_assert(WS_FW + 11534336 + 5767168 <= WS_U, "ws map");
static_assert(WS_WIN + 11010048 == WS_WAO, "ws map");

typedef float f32x2_t __attribute__((ext_vector_type(2)));
typedef __bf16 bf16x2_t __attribute__((ext_vector_type(2)));
__device__ __forceinline__ unsigned pk2(float lo, float hi) { const f32x2_t v = {lo, hi}; const bf16x2_t b = __builtin_convertvector(v, bf16x2_t); return __builtin_bit_cast(unsigned, b); }
__device__ __forceinline__ float bflo(unsigned u) { return __uint_as_float(u << 16); }
__device__ __forceinline__ float bfhi(unsigned u) { return __uint_as_float(u & 0xffff0000u); }
__device__ __forceinline__ float sigmoidf_(float x) { return __builtin_amdgcn_rcpf(1.0f + __builtin_amdgcn_exp2f(-1.4426950408889634f * x)); }
__device__ __forceinline__ float siluf_(float x) { return x * sigmoidf_(x); }
__device__ __forceinline__ unsigned pkh2(float lo, float hi) {
    const unsigned a = (unsigned)__builtin_bit_cast(unsigned short, (_Float16)lo), b = (unsigned)__builtin_bit_cast(unsigned short, (_Float16)hi);
    return a | (b << 16);
}
__device__ __forceinline__ float hlo(unsigned u) { return (float)__builtin_bit_cast(_Float16, (unsigned short)(u & 0xffffu)); }
__device__ __forceinline__ float hhi(unsigned u) { return (float)__builtin_bit_cast(_Float16, (unsigned short)(u >> 16)); }
__device__ __forceinline__ float wave_sum(float v) {
#pragma unroll
    for (int o = 32; o >= 1; o >>= 1) v += __shfl_xor(v, o);
    return v;
}


struct Params {
    const float* in[19];
    float* out;
    unsigned char* ws;
};

__device__ __forceinline__ int map_row(int mode, int n) {
    if (mode == 1) { if (n < 768) { const int tile = n >> 8, w = n & 255, wcq = w >> 6, rem = w & 63, bj = rem >> 5, i = rem & 31; return (tile << 8) + (bj << 7) + (wcq << 5) + i; } return n; }
    if (mode == 2) return ((n >> 7) << 8) + (n & 127);
    if (mode == 3) return ((n >> 7) << 8) + 128 + (n & 127);
    return n;
}
__device__ __forceinline__ void transpose_tile(const float* __restrict__ src, int K, int N, bf16_t* __restrict__ dst, int ld, int mode, int tk, int tn, LAS float* scr) {
    const int tid = opaque_tid();
#pragma unroll
    for (int p = 0; p < 8; ++p) { const int kr = p * 8 + (tid >> 6), nc = tid & 63; scr[nc * 65 + kr] = src[(size_t)(tk * 64 + kr) * N + tn * 64 + nc]; }
    __syncthreads();
    { const int n = tid >> 3, ch = tid & 7; const int nm = map_row(mode, tn * 64 + n);
      float v[8];
#pragma unroll
      for (int j = 0; j < 8; ++j) v[j] = scr[n * 65 + ch * 8 + j];
      u32x4 w; w.x = pk2(v[0], v[1]); w.y = pk2(v[2], v[3]); w.z = pk2(v[4], v[5]); w.w = pk2(v[6], v[7]);
      *(u32x4*)(dst + (size_t)nm * ld + tk * 64 + ch * 8) = w; }
    __syncthreads();
}
struct TJob { const float* src; int K, N; bf16_t* dst; int mode; int ld, koff; };
__device__ __forceinline__ TJob get_job(const Params& p, int set, int j) {
    unsigned char* ws = p.ws;
    if (set == 0) {
        switch (j) {
            case 0: return TJob{p.in[11], D, DIN, (bf16_t*)(ws + WS_WIN), 1, D, 0};
            case 1: return TJob{p.in[8], D, DFF, (bf16_t*)(ws + WS_FW), 2, D, 0};
            case 2: return TJob{p.in[9], D, DFF, (bf16_t*)(ws + WS_FW), 3, D, 0};
            case 3: return TJob{p.in[10], DFF, D, (bf16_t*)(ws + WS_FW + 11534336), 0, DFF, 0};
            case 4: return TJob{p.in[16], 512, D, (bf16_t*)(ws + WS_WAO), 0, 1024, 0};
            case 5: return TJob{p.in[17], 512, D, (bf16_t*)(ws + WS_WAO), 0, 1024, 512};
            default: return TJob{p.in[18], D, D, (bf16_t*)(ws + WS_WO), 0, D, 0};
        }
    }
    switch (j) {
        case 0: return TJob{p.in[8] + (size_t)D * DFF, D, DFF, (bf16_t*)(ws + WS_Q), 2, D, 0};
        case 1: return TJob{p.in[9] + (size_t)D * DFF, D, DFF, (bf16_t*)(ws + WS_Q), 3, D, 0};
        default: return TJob{p.in[10] + (size_t)D * DFF, DFF, D, (bf16_t*)(ws + WS_Q + 11534336), 0, DFF, 0};
    }
}
__device__ __forceinline__ void transpose_jobs(const Params& p, int set, int njobs, LAS float* scr) {
    int total = 0;
    for (int j = 0; j < njobs; ++j) { const TJob jb = get_job(p, set, j); total += (jb.K >> 6) * (jb.N >> 6); }
    const int G = (int)gridDim.x, bx = (int)blockIdx.x;
    const bool weighted = (set == 0) && (G > 144);
    const int nw = weighted ? 144 + 2 * (G - 144) : G;
    const int w0 = weighted ? (bx < 144 ? bx : 144 + 2 * (bx - 144)) : bx;
    const int nmine = (weighted && bx >= 144) ? 2 : 1;
    for (int k = 0; k < nmine; ++k)
    for (int t = w0 + k; t < total; t += nw) {
        int r = t, j = 0;
        for (; j < njobs - 1; ++j) { const TJob jb = get_job(p, set, j); const int c = (jb.K >> 6) * (jb.N >> 6); if (r < c) break; r -= c; }
        const TJob jb = get_job(p, set, j);
        const int ntn = jb.N >> 6;
        transpose_tile(jb.src, jb.K, jb.N, jb.dst + jb.koff, jb.ld, jb.mode, r / ntn, r % ntn, scr);
    }
}

__device__ __forceinline__ void mod_task(const Params& p, int ct, LAS float* lds) {
    const float* c = p.in[1]; const float* cctx = p.in[3]; const float* wm = p.in[4]; const float* bm = p.in[5];
    float* mod = (float*)(p.ws + WS_MOD);
    LAS float* sc = lds;
    LAS float* red = lds + 1024 * 20;
    const int tid = opaque_tid();
    for (int e = tid; e < 17 * 1024; e += NTHREADS) { const int i = e >> 10, k = e & 1023; const float v = (i < 16) ? c[i * 1024 + k] : cctx[k]; sc[k * 20 + i] = siluf_(v); }
    __syncthreads();
    const int col = tid & 63, ks = tid >> 6;
    float acc[17];
#pragma unroll
    for (int i = 0; i < 17; ++i) acc[i] = 0.f;
    const float* wp = wm + (size_t)(ks * 128) * (NMOD * D) + ct * 64 + col;
#pragma unroll 16
    for (int k = 0; k < 128; ++k) {
        const float w = wp[(size_t)k * (NMOD * D)];
        const LAS f32x4* s4 = (const LAS f32x4*)(sc + (ks * 128 + k) * 20);
        const f32x4 a = s4[0], b = s4[1], cc = s4[2], d = s4[3]; const float e = sc[(ks * 128 + k) * 20 + 16];
        acc[0] += a[0] * w; acc[1] += a[1] * w; acc[2] += a[2] * w; acc[3] += a[3] * w;
        acc[4] += b[0] * w; acc[5] += b[1] * w; acc[6] += b[2] * w; acc[7] += b[3] * w;
        acc[8] += cc[0] * w; acc[9] += cc[1] * w; acc[10] += cc[2] * w; acc[11] += cc[3] * w;
        acc[12] += d[0] * w; acc[13] += d[1] * w; acc[14] += d[2] * w; acc[15] += d[3] * w;
        acc[16] += e * w;
    }
#pragma unroll
    for (int i = 0; i < 17; ++i) red[(ks * 17 + i) * 64 + col] = acc[i];
    __syncthreads();
    for (int e = tid; e < 17 * 64; e += NTHREADS) {
        const int i = e >> 6, cl = e & 63; float s = 0.f;
#pragma unroll
        for (int q = 0; q < 8; ++q) s += red[(q * 17 + i) * 64 + cl];
        mod[i * (NMOD * D) + ct * 64 + cl] = s + bm[ct * 64 + cl];
    }
    __syncthreads();
}

__device__ __forceinline__ void p0_prep(const Params& p, LAS unsigned char* lds) {
    LAS float* fl = (LAS float*)lds;
    const int tid = opaque_tid();
    for (int t = (int)blockIdx.x; t < 144; t += (int)gridDim.x) mod_task(p, t, fl);
    if (blockIdx.x == gridDim.x - 1) {
        float* lb = (float*)(p.ws + WS_LB); const float* hlb = p.in[14];
        for (int e = tid; e < 1024; e += NTHREADS) { const int dir = e >> 9, ch = e & 511; const float a0 = hlb[dir * 1024 + ch], a1 = hlb[dir * 1024 + 512 + ch]; lb[e] = 1.0f / (1.0f + __expf(a1 - a0)); }
        if (tid == 0) {
            float mq = 0.f, mk = 0.f;
            for (int i = 0; i < 64; ++i) { mq = fmaxf(mq, fabsf(p.in[12][i])); mk = fmaxf(mk, fabsf(p.in[13][i])); }
            ((float*)(p.ws + WS_ROPE))[2048] = 64.0f * mq * mk * (0.125f * 1.4426950408889634f) * 1.02f;
        }
        float* rope = (float*)(p.ws + WS_ROPE);
        for (int e = tid; e < 1024; e += NTHREADS) { const int pos = e >> 4, pp = e & 15; const float inv = exp2f(-(float)pp * (13.287712379549449f / 16.0f)); const float ang = (float)pos * inv;
            rope[e * 2] = __cosf(ang); rope[e * 2 + 1] = __sinf(ang); }

    }
    transpose_jobs(p, 0, 7, fl);
}

#define NP_LOAD(R, HH, YY, XX) do { const int r_ = (R); \
    if (hb) { _Pragma("unroll") for (int i = 0; i < 4; ++i) XX[i] = *(const u32x2*)(hb + (size_t)r_ * D + 256 * i + 4 * lane); } \
    else { const float* hrow_ = (r_ < TL) ? hx + (size_t)r_ * D : hc + (size_t)(r_ - TL) * D; \
        _Pragma("unroll") for (int i = 0; i < 4; ++i) HH[i] = *(const f32x4*)(hrow_ + 256 * i + 4 * lane); } \
    if (Y) { _Pragma("unroll") for (int i = 0; i < 4; ++i) YY[i] = *(const u32x2*)(Y + (size_t)r_ * D + 256 * i + 4 * lane); } } while (0)
#define NP_BODY(R, HH, YY, XX) do { const int r_ = (R); \
    const int bi_ = (r_ < TL) ? (r_ >> 11) : 16; \
    if (hb) { _Pragma("unroll") for (int i = 0; i < 4; ++i) HH[i] = (f32x4){bflo(XX[i].x), bfhi(XX[i].x), bflo(XX[i].y), bfhi(XX[i].y)}; } \
    if (bi_ != curb) { curb = bi_; const float* mrow = mod + bi_ * (NMOD * D); \
        _Pragma("unroll") for (int i = 0; i < 4; ++i) { if (Y) gt[i] = *(const f32x4*)(mrow + gate_idx * D + 256 * i + 4 * lane); \
            if (U) { sh[i] = *(const f32x4*)(mrow + shift_idx * D + 256 * i + 4 * lane); sc[i] = *(const f32x4*)(mrow + scale_idx * D + 256 * i + 4 * lane) + 1.0f; } } } \
    if (Y) { f32x4 y[4]; float ss = 0.f; \
        _Pragma("unroll") for (int i = 0; i < 4; ++i) { y[i] = (f32x4){bflo(YY[i].x), bfhi(YY[i].x), bflo(YY[i].y), bfhi(YY[i].y)}; \
            ss += y[i][0] * y[i][0] + y[i][1] * y[i][1] + y[i][2] * y[i][2] + y[i][3] * y[i][3]; } \
        ss = wave_sum(ss); const float rstd = rsqrtf(ss * (1.0f / D) + EPS) * coef; \
        _Pragma("unroll") for (int i = 0; i < 4; ++i) HH[i] += gt[i] * (y[i] * rstd * gpo[i]); } \
    if (hob && r_ < TL) { _Pragma("unroll") for (int i = 0; i < 4; ++i) { u32x2 w; w.x = pk2(HH[i][0], HH[i][1]); w.y = pk2(HH[i][2], HH[i][3]); \
        *(u32x2*)(hob + (size_t)r_ * D + 256 * i + 4 * lane) = w; \
        HH[i] = (f32x4){bflo(w.x), bfhi(w.x), bflo(w.y), bfhi(w.y)}; } }     \
    if (hout && r_ < TL) { _Pragma("unroll") for (int i = 0; i < 4; ++i) *(f32x4*)(hout + (size_t)r_ * D + 256 * i + 4 * lane) = HH[i]; } \
    if (U) { float ss = 0.f; \
        _Pragma("unroll") for (int i = 0; i < 4; ++i) ss += HH[i][0] * HH[i][0] + HH[i][1] * HH[i][1] + HH[i][2] * HH[i][2] + HH[i][3] * HH[i][3]; \
        ss = wave_sum(ss); const float rstd = rsqrtf(ss * (1.0f / D) + EPS); \
        _Pragma("unroll") for (int i = 0; i < 4; ++i) { const f32x4 u = (HH[i] * rstd * gpr[i]) * sc[i] + sh[i]; \
            u32x2 w; w.x = pk2(u[0], u[1]); w.y = pk2(u[2], u[3]); *(u32x2*)(U + (size_t)r_ * D + 256 * i + 4 * lane) = w; } } } while (0)
__device__ __forceinline__ void norm_pass(const bf16_t* __restrict__ Y, const float* hx, const float* hc, const bf16_t* hb, const float* __restrict__ mod,
                                          const float* __restrict__ gpost, int gate_idx, float coef, float* hout, bf16_t* hob,
                                          const float* __restrict__ gpre, int shift_idx, int scale_idx, bf16_t* __restrict__ U, int nrows) {
    const int tid_ = opaque_tid(); const int lane = tid_ & 63, wave = tid_ >> 6;
    const int W = (int)gridDim.x * 8, gw = (int)blockIdx.x * 8 + wave;
    const int rpw = (((nrows + W - 1) / W) + 1) & ~1;
    const int r0 = gw * rpw, r1 = (r0 + rpw < nrows) ? r0 + rpw : nrows;
    if (r0 < r1) {
        f32x4 gpo[4], gpr[4], gt[4], sh[4], sc[4];
#pragma unroll
        for (int i = 0; i < 4; ++i) { gpo[i] = Y ? *(const f32x4*)(gpost + 256 * i + 4 * lane) : (f32x4){0.f, 0.f, 0.f, 0.f}; gpr[i] = U ? *(const f32x4*)(gpre + 256 * i + 4 * lane) : (f32x4){0.f, 0.f, 0.f, 0.f};
            gt[i] = sh[i] = sc[i] = (f32x4){0.f, 0.f, 0.f, 0.f}; }
        int curb = -1;
        f32x4 hA[4], hB[4]; u32x2 yA[4], yB[4], xA[4], xB[4];
#pragma unroll
        for (int i = 0; i < 4; ++i) { yA[i] = yB[i] = xA[i] = xB[i] = (u32x2){0u, 0u}; hA[i] = hB[i] = (f32x4){0.f, 0.f, 0.f, 0.f}; }
        NP_LOAD(r0, hA, yA, xA);
        if (r0 + 1 < r1) NP_LOAD(r0 + 1, hB, yB, xB);
        for (int r = r0; r < r1; r += 2) {
            f32x4 hAn[4], hBn[4]; u32x2 yAn[4], yBn[4], xAn[4], xBn[4];
#pragma unroll
            for (int i = 0; i < 4; ++i) { hAn[i] = hBn[i] = (f32x4){0.f, 0.f, 0.f, 0.f}; yAn[i] = yBn[i] = xAn[i] = xBn[i] = (u32x2){0u, 0u}; }
            if (r + 2 < r1) NP_LOAD(r + 2, hAn, yAn, xAn);
            if (r + 3 < r1) NP_LOAD(r + 3, hBn, yBn, xBn);
            NP_BODY(r, hA, yA, xA);
            if (r + 1 < r1) NP_BODY(r + 1, hB, yB, xB);
#pragma unroll
            for (int i = 0; i < 4; ++i) { hA[i] = hAn[i]; yA[i] = yAn[i]; xA[i] = xAn[i]; hB[i] = hBn[i]; yB[i] = yBn[i]; xB[i] = xBn[i]; }
        }
    }
}

struct InOrder {
    pg8::StaticOrder so;
    __device__ void init(int G, int c) { so.init(TL, DIN, G, c); }
    __device__ bool next(int i, Unit& u) const {
        const long L = (long)i * so.G + so.c;
        if (L < so.nwg) return so.next(i, u);
        const int e = (int)(L - so.nwg); if (e >= 112) return false;
        const int pi = e >> 4; u.pm = 128 + (e & 15); u.pn = (pi == 0) ? 2 : (4 + pi); return true;
    }
    __device__ __forceinline__ void a_ready(const Unit&) const {}
    __device__ __forceinline__ void done(const Unit&) const {}
};

struct EpiSwiGLU {
    static constexpr bool PERM = true, AFTER_DRAIN = false, HAS_MID = false;
    bf16_t* H;
    __device__ __forceinline__ void operator()(const f32x4 (&acc)[2][2][4][2], const Unit& u, int wr, int wc, int fr, int fq) const {
        const int row0 = u.pm * 256 + wr * 64 + fr, col0 = u.pn * 128 + wc * 32 + 8 * fq;
#pragma unroll
        for (int ai = 0; ai < 2; ++ai)
#pragma unroll
            for (int m = 0; m < 4; ++m) {
                float v[8];
#pragma unroll
                for (int n = 0; n < 2; ++n)
#pragma unroll
                    for (int j = 0; j < 4; ++j) v[n * 4 + j] = siluf_(acc[ai][0][m][n][j]) * acc[ai][1][m][n][j];
                u32x4 w; w.x = pk2(v[0], v[1]); w.y = pk2(v[2], v[3]); w.z = pk2(v[4], v[5]); w.w = pk2(v[6], v[7]);
                *(u32x4*)(H + (size_t)(row0 + ai * 128 + m * 16) * DFF + col0) = w;
            }
    }
};
struct EpiStore {
    static constexpr bool PERM = true, AFTER_DRAIN = false, HAS_MID = false;
    bf16_t* O; int ldc;
    __device__ __forceinline__ void operator()(const f32x4 (&acc)[2][2][4][2], const Unit& u, int wr, int wc, int fr, int fq) const {
        const int row0 = u.pm * 256 + wr * 64 + fr, col0 = u.pn * 256 + wc * 32 + 8 * fq;
#pragma unroll
        for (int ai = 0; ai < 2; ++ai)
#pragma unroll
            for (int m = 0; m < 4; ++m)
#pragma unroll
                for (int bj = 0; bj < 2; ++bj) {
                    const f32x4 a = acc[ai][bj][m][0], b = acc[ai][bj][m][1];
                    u32x4 w; w.x = pk2(a[0], a[1]); w.y = pk2(a[2], a[3]); w.z = pk2(b[0], b[1]); w.w = pk2(b[2], b[3]);
                    *(u32x4*)(O + (size_t)(row0 + ai * 128 + m * 16) * ldc + col0 + bj * 128) = w;
                }
    }
};
struct EpiMerge2 {
    static constexpr bool PERM = true, AFTER_DRAIN = false, HAS_MID = true;
    bf16_t* Yo; const bf16_t* P;
    __device__ __forceinline__ void mid(f32x4 (&acc)[2][2][4][2], const Unit& u, int wr, int wc, int fr, int fq) const {
        asm volatile("" : "+v"(fr), "+v"(fq));
        const int row0 = u.pm * 256 + wr * 64 + fr, col0 = u.pn * 256 + wc * 32 + 8 * fq;
#pragma unroll
        for (int ai = 0; ai < 2; ++ai)
#pragma unroll
            for (int m = 0; m < 4; ++m)
#pragma unroll
                for (int bj = 0; bj < 2; ++bj) {
                    const size_t r = (size_t)(row0 + ai * 128 + m * 16); const int c = col0 + bj * 128;
                    const u32x4 ga = *(const u32x4*)(P + r * PW + 2560 + c), gb = *(const u32x4*)(P + r * PW + 3584 + c);
                    const float q0 = bflo(ga.x) * __builtin_amdgcn_rcpf(bflo(gb.x)), q1 = bfhi(ga.x) * __builtin_amdgcn_rcpf(bfhi(gb.x));
                    const float q2 = bflo(ga.y) * __builtin_amdgcn_rcpf(bflo(gb.y)), q3 = bfhi(ga.y) * __builtin_amdgcn_rcpf(bfhi(gb.y));
                    const float q4 = bflo(ga.z) * __builtin_amdgcn_rcpf(bflo(gb.z)), q5 = bfhi(ga.z) * __builtin_amdgcn_rcpf(bfhi(gb.z));
                    const float q6 = bflo(ga.w) * __builtin_amdgcn_rcpf(bflo(gb.w)), q7 = bfhi(ga.w) * __builtin_amdgcn_rcpf(bfhi(gb.w));
                    acc[ai][bj][m][0] *= (f32x4){q0, q1, q2, q3}; acc[ai][bj][m][1] *= (f32x4){q4, q5, q6, q7};
                    asm volatile("" ::: "memory");
                }
    }
    __device__ __forceinline__ void operator()(const f32x4 (&acc)[2][2][4][2], const Unit& u, int wr, int wc, int fr, int fq) const {
        const int row0 = u.pm * 256 + wr * 64 + fr, col0 = u.pn * 256 + wc * 32 + 8 * fq;
#pragma unroll
        for (int ai = 0; ai < 2; ++ai)
#pragma unroll
            for (int m = 0; m < 4; ++m)
#pragma unroll
                for (int bj = 0; bj < 2; ++bj) {
                    const size_t r = (size_t)(row0 + ai * 128 + m * 16); const int c = col0 + bj * 128;
                    const u32x4 g = *(const u32x4*)(P + r * PW + 3584 + c);
                    const f32x4 a = acc[ai][bj][m][0], b = acc[ai][bj][m][1];
                    u32x4 w; w.x = pk2(a[0] * bflo(g.x), a[1] * bfhi(g.x)); w.y = pk2(a[2] * bflo(g.y), a[3] * bfhi(g.y)); w.z = pk2(b[0] * bflo(g.z), b[1] * bfhi(g.z)); w.w = pk2(b[2] * bflo(g.w), b[3] * bfhi(g.w));
                    *(u32x4*)(Yo + r * D + c) = w;
                }
    }
};
struct EpiIn {
    static constexpr bool PERM = true, AFTER_DRAIN = false, HAS_MID = false;
    bf16_t* P; bf16_t* Pc; bf16_t* Qn; bf16_t* Kn; bf16_t* Vt; const float* qg; const float* kg; const float* lb; const float* rope;
    __device__ __forceinline__ void operator()(const f32x4 (&acc)[2][2][4][2], const Unit& u, int wr, int wc, int fr, int fq) const {
        const int pn = u.pn; const bool isctx = u.pm >= 128;
        const int row0 = u.pm * 256 + wr * 64 + fr;
        if (pn <= 2) {
            if (pn == 2 && wc >= 2) {
                const int kvh = wc - 2;
#pragma unroll
                for (int ai = 0; ai < 2; ++ai)
#pragma unroll
                    for (int m = 0; m < 4; ++m) {
                        const int row = row0 + ai * 128 + m * 16;
                        int b, key; if (!isctx) { b = row >> 11; key = row & 2047; } else { const int rc = row - TL; b = rc >> 8; key = SEQ + (rc & 255); }
                        bf16_t* base = Vt + (size_t)((b * 2 + kvh) * 64) * NKEY + key;
#pragma unroll
                        for (int bj = 0; bj < 2; ++bj)
#pragma unroll
                            for (int n = 0; n < 2; ++n)
#pragma unroll
                                for (int j = 0; j < 4; j += 2) {
                                    const unsigned w = pk2(acc[ai][bj][m][n][j], acc[ai][bj][m][n][j + 1]);
                                    const int d = 32 * bj + 8 * fq + 4 * n + j;
                                    base[(size_t)d * NKEY] = (bf16_t)(w & 0xffffu); base[(size_t)(d + 1) * NKEY] = (bf16_t)(w >> 16);
                                }
                    }
            } else {
                const bool isk = (pn == 2);
                const float* gain = isk ? kg : qg;
                float gn[2][8];
#pragma unroll
                for (int bj = 0; bj < 2; ++bj)
#pragma unroll
                    for (int e = 0; e < 8; ++e) gn[bj][e] = gain[32 * bj + 8 * fq + e];
                const float osc = isk ? 1.0f : (0.125f * 1.4426950408889634f);
#pragma unroll
                for (int ai = 0; ai < 2; ++ai)
#pragma unroll
                    for (int m = 0; m < 4; ++m) {
                        const int row = row0 + ai * 128 + m * 16;
                        float y[2][8]; float ss = 0.f;
#pragma unroll
                        for (int bj = 0; bj < 2; ++bj)
#pragma unroll
                            for (int n = 0; n < 2; ++n)
#pragma unroll
                                for (int j = 0; j < 4; ++j) { const float v = acc[ai][bj][m][n][j]; y[bj][n * 4 + j] = v; ss += v * v; }
                        ss += __shfl_xor(ss, 16); ss += __shfl_xor(ss, 32);
                        const float rstd = rsqrtf(ss * (1.0f / 64.0f) + EPS);
#pragma unroll
                        for (int bj = 0; bj < 2; ++bj)
#pragma unroll
                            for (int e = 0; e < 8; ++e) y[bj][e] *= rstd * gn[bj][e];
                        if (!isctx) {
                            const int t = row & 2047;
#pragma unroll
                            for (int bj = 0; bj < 2; ++bj) {
                                const int pos = bj ? (t & 63) : (t >> 6);
                                const float* rp = rope + (pos * 16 + 8 * (fq & 1)) * 2;
#pragma unroll
                                for (int e = 0; e < 8; e += 2) {
                                    const f32x4 cs = *(const f32x4*)(rp + e * 2);
                                    const float p0 = __shfl_xor(y[bj][e], 32), p1 = __shfl_xor(y[bj][e + 1], 32);
                                    const float s0 = (fq >> 1) ? p0 : -p0, s1 = (fq >> 1) ? p1 : -p1;
                                    y[bj][e] = y[bj][e] * cs[0] + s0 * cs[1]; y[bj][e + 1] = y[bj][e + 1] * cs[2] + s1 * cs[3];
                                }
                            }
                        }
                        bf16_t* dst;
                        if (!isk) dst = Qn + (size_t)row * 512 + (4 * pn + wc) * 64 + 8 * fq;
                        else { int b, key; if (!isctx) { b = row >> 11; key = row & 2047; } else { const int rc = row - TL; b = rc >> 8; key = SEQ + (rc & 255); }
                               dst = Kn + ((size_t)(b * 2 + wc) * NKEY + key) * 64 + 8 * fq; }
#pragma unroll
                        for (int bj = 0; bj < 2; ++bj) {
                            u32x4 w; w.x = pk2(y[bj][0] * osc, y[bj][1] * osc); w.y = pk2(y[bj][2] * osc, y[bj][3] * osc); w.z = pk2(y[bj][4] * osc, y[bj][5] * osc); w.w = pk2(y[bj][6] * osc, y[bj][7] * osc);
                            *(u32x4*)(dst + 32 * bj) = w;
                        }
                    }
            }
        } else {
            const int cls = (pn <= 4) ? 0 : (pn <= 6) ? 1 : (pn <= 8) ? 2 : (pn <= 10) ? 3 : (pn <= 12) ? 4 : 5;
#pragma unroll
            for (int bj = 0; bj < 2; ++bj) {
                const int c = pn * 256 + bj * 128 + wc * 32 + 8 * fq;
                float lbv[8];
                if (cls == 2 || cls == 3) {
                    const float* lp = lb + (cls == 3 ? 512 : 0) + (c - (cls == 3 ? 2304 : 1792));
#pragma unroll
                    for (int e = 0; e < 8; ++e) lbv[e] = 1.0f - lp[e];
                }
#pragma unroll
                for (int ai = 0; ai < 2; ++ai)
#pragma unroll
                    for (int m = 0; m < 4; ++m) {
                        const int row = row0 + ai * 128 + m * 16;
                        float v[8];
#pragma unroll
                        for (int n = 0; n < 2; ++n)
#pragma unroll
                            for (int j = 0; j < 4; ++j) v[n * 4 + j] = acc[ai][bj][m][n][j];
                        u32x4 w;
                        if (cls == 0) {
#pragma unroll
                            for (int e = 0; e < 8; ++e) v[e] = siluf_(v[e]) * 0.08838834764831845f; }
                        else if (cls == 4) {
#pragma unroll
                            for (int e = 0; e < 8; ++e) v[e] = siluf_(v[e]); }
                        else if (cls == 5) {
#pragma unroll
                            for (int e = 0; e < 8; ++e) v[e] = sigmoidf_(v[e]); }
                        if (cls == 2 || cls == 3) {
#pragma unroll
                            for (int e = 0; e < 8; ++e) v[e] = lbv[e] * sigmoidf_(-v[e]);
                            w.x = pkh2(v[0], v[1]); w.y = pkh2(v[2], v[3]); w.z = pkh2(v[4], v[5]); w.w = pkh2(v[6], v[7]);
                        } else { w.x = pk2(v[0], v[1]); w.y = pk2(v[2], v[3]); w.z = pk2(v[4], v[5]); w.w = pk2(v[6], v[7]); }
                        if (!isctx) *(u32x4*)(P + (size_t)row * PW + (c - 768)) = w;
                        else *(u32x4*)(Pc + (size_t)(row - TL) * PCW + (c - 1280)) = w;
                    }
            }
        }
    }
};

constexpr int AK_PITCH = 144, AV_PITCH = 136, AK_BYTES = 64 * AK_PITCH, AV_BYTES = 64 * AV_PITCH;
constexpr int ATILE_BYTES = AK_BYTES + AV_BYTES;
#define ATT_TILE(TT_, SC_, SN_) do { \
        const int tl = (TT_ + 2 < NT) ? TT_ + 2 : NT - 1; \
        const u32x4 kreg = *(const u32x4*)(Kb + (size_t)(tl * 64 + srow) * 64 + sch * 8); \
        const u32x4 vreg = *(const u32x4*)(Vb + (size_t)srow * NKEY + tl * 64 + sch * 8); \
_Pragma("unroll") \
        for (int kb = 0; kb < 2; ++kb) { \
_Pragma("unroll") \
            for (int i = 0; i < 16; ++i) SN_[kb][i] = 0.f; \
_Pragma("unroll") \
            for (int ks = 0; ks < 4; ++ks) { const bf16x8 a = *(const LAS bf16x8*)(lds + bufn + kroff + 32 * kb * AK_PITCH + 32 * ks); \
                SN_[kb] = __builtin_amdgcn_mfma_f32_32x32x16_bf16(a, qf[ks], SN_[kb], 0, 0, 0); } \
        } \
        f32x2_t m2 = {0.f, 0.f}; \
        if (!BOUNDED) { \
            float mx = SC_[0][0]; \
_Pragma("unroll") \
            for (int i = 1; i < 16; ++i) mx = fmaxf(mx, SC_[0][i]); \
_Pragma("unroll") \
            for (int i = 0; i < 16; ++i) mx = fmaxf(mx, SC_[1][i]); \
            mx = fmaxf(mx, __shfl_xor(mx, 32)); \
            const float mnew = fmaxf(mrun, mx); \
            if (__any(mnew > mrun)) { \
                const float alpha = __builtin_amdgcn_exp2f(mrun - mnew); \
                lrun *= alpha; \
_Pragma("unroll") \
                for (int i = 0; i < 16; ++i) { o[0][i] *= alpha; o[1][i] *= alpha; } \
            } \
            mrun = mnew; \
            m2 = (f32x2_t){mnew, mnew}; \
        } \
        float psx = 0.f, psy = 0.f; \
        u32x4 pw[2][2]; \
_Pragma("unroll") \
        for (int kb = 0; kb < 2; ++kb) \
_Pragma("unroll") \
            for (int ks = 0; ks < 2; ++ks) { \
                unsigned w4[4]; \
_Pragma("unroll") \
                for (int j2 = 0; j2 < 4; ++j2) { \
                    f32x2_t v = (f32x2_t){SC_[kb][8 * ks + 2 * j2], SC_[kb][8 * ks + 2 * j2 + 1]}; \
                    if (!BOUNDED) v -= m2; \
                    v.x = __builtin_amdgcn_exp2f(v.x); v.y = __builtin_amdgcn_exp2f(v.y); \
                    psx += v.x; psy += v.y; w4[j2] = pk2(v.x, v.y); \
                } \
                pw[kb][ks] = (u32x4){w4[0], w4[1], w4[2], w4[3]}; \
            } \
        lrun += psx + psy; \
_Pragma("unroll") \
        for (int kb = 0; kb < 2; ++kb) \
_Pragma("unroll") \
            for (int ks = 0; ks < 2; ++ks) { \
                const bf16x8 pf = __builtin_bit_cast(bf16x8, pw[kb][ks]); \
_Pragma("unroll") \
                for (int db = 0; db < 2; ++db) { \
                    LAS unsigned char* vp = lds + bufc + vroff + 32 * db * AV_PITCH + (32 * kb + 16 * ks) * 2; \
                    const u32x2 lo = *(const LAS u32x2*)vp, hi = *(const LAS u32x2*)(vp + 16); \
                    const bf16x8 a = __builtin_bit_cast(bf16x8, (u32x4){lo.x, lo.y, hi.x, hi.y}); \
                    o[db] = __builtin_amdgcn_mfma_f32_32x32x16_bf16(a, pf, o[db], 0, 0, 0); \
                } \
            } \
        *(LAS u32x4*)(lds + bufw + kwoff) = kreg; \
        { LAS u32x2* vp = (LAS u32x2*)(lds + bufw + vwoff); vp[0] = (u32x2){vreg.x, vreg.y}; vp[1] = (u32x2){vreg.z, vreg.w}; } \
        __syncthreads(); \
        { const int tmp = bufc; bufc = bufn; bufn = bufw; bufw = tmp; } \
    } while (0)
template <bool BOUNDED>
__device__ __forceinline__ void attn_unit(int unit, float cb, const bf16_t* __restrict__ Kn, const bf16_t* __restrict__ Vt, const bf16_t* __restrict__ QO, bf16_t* __restrict__ OM, LAS unsigned char* lds) {
    const int g = unit & 3, qb = (unit >> 2) & 7, bk = unit >> 5, b = bk >> 1, kvh = bk & 1, h = kvh * 4 + g;
    const int tid = opaque_tid(), wave = tid >> 6, lane = tid & 63, r32 = lane & 31, hh = lane >> 5;
    const size_t tok = (size_t)b * SEQ + qb * 256 + wave * 32 + r32;
    bf16x8 qf[4];
#pragma unroll
    for (int s = 0; s < 4; ++s) qf[s] = *(const bf16x8*)(QO + tok * 512 + h * 64 + 16 * s + 8 * hh);
    const bf16_t* Kb = Kn + (size_t)bk * NKEY * 64; const bf16_t* Vb = Vt + (size_t)bk * 64 * NKEY;
    const int srow = tid >> 3, sch = tid & 7;
    const int kwoff = srow * AK_PITCH + sch * 16, vwoff = AK_BYTES + srow * AV_PITCH + sch * 16;
    const int kroff = r32 * AK_PITCH + 16 * hh, vroff = AK_BYTES + r32 * AV_PITCH + 8 * hh;
    f32x16 o[2];
#pragma unroll
    for (int i = 0; i < 16; ++i) { o[0][i] = 0.f; o[1][i] = 0.f; }
    float mrun = -1e30f, lrun = 0.f;
    constexpr int NT = NKEY / 64;
#pragma unroll
    for (int sb = 0; sb < 2; ++sb) {
        const u32x4 kr = *(const u32x4*)(Kb + (size_t)(sb * 64 + srow) * 64 + sch * 8);
        const u32x4 vr = *(const u32x4*)(Vb + (size_t)srow * NKEY + sb * 64 + sch * 8);
        *(LAS u32x4*)(lds + sb * ATILE_BYTES + kwoff) = kr;
        LAS u32x2* vp = (LAS u32x2*)(lds + sb * ATILE_BYTES + vwoff); vp[0] = (u32x2){vr.x, vr.y}; vp[1] = (u32x2){vr.z, vr.w};
    }
    __syncthreads();
    f32x16 sc[2];
#pragma unroll
    for (int kb = 0; kb < 2; ++kb) {
#pragma unroll
        for (int i = 0; i < 16; ++i) sc[kb][i] = 0.f;
#pragma unroll
        for (int ks = 0; ks < 4; ++ks) { const bf16x8 a = *(const LAS bf16x8*)(lds + kroff + 32 * kb * AK_PITCH + 32 * ks);
            sc[kb] = __builtin_amdgcn_mfma_f32_32x32x16_bf16(a, qf[ks], sc[kb], 0, 0, 0); }
    }
    int bufc = 0, bufn = ATILE_BYTES, bufw = 2 * ATILE_BYTES;
    f32x16 sd[2];
    for (int t = 0; t < NT; t += 2) {
        ATT_TILE(t, sc, sd);
        ATT_TILE(t + 1, sd, sc);
    }
    const float l = lrun + __shfl_xor(lrun, 32); const float inv = 1.0f / l;
#pragma unroll
    for (int db = 0; db < 2; ++db)
#pragma unroll
        for (int g4 = 0; g4 < 4; ++g4) {
            u32x2 w; w.x = pk2(o[db][4 * g4] * inv, o[db][4 * g4 + 1] * inv); w.y = pk2(o[db][4 * g4 + 2] * inv, o[db][4 * g4 + 3] * inv);
            *(u32x2*)(OM + tok * 1024 + h * 64 + 32 * db + 8 * g4 + 4 * hh) = w;
        }
}

constexpr int HQ1 = 0, HK1 = 17408, HQH = 34816, HKT = 52224, HVT = 68608, HAI = 84992, HTOT = 94208, HEL = 102400;
constexpr int HP = 272;
__device__ __forceinline__ int swz128(int row, int s) { return row * 128 + (((((s >> 3) ^ (row >> 3) ^ (row >> 1)) & 7)) << 4) + (s & 7) * 2; }
__device__ __forceinline__ void hgrn_item(int item, const bf16_t* __restrict__ P, const bf16_t* __restrict__ Pc, bf16_t* __restrict__ OHF, bf16_t* __restrict__ OHB, LAS unsigned char* lds) {
    const int dir = item & 1, head = (item >> 1) & 3, b = item >> 3;
    const int tid = opaque_tid(), w = tid >> 6, lane = tid & 63, l15 = lane & 15, q4 = lane >> 4;
    const int cgi = tid & 31, sg = tid >> 5;
    const int sp = tid >> 4, vg = tid & 15;
    bf16_t* Oout = dir ? OHB : OHF;
    f32x4 S[8];
#pragma unroll
    for (int i = 0; i < 8; ++i) S[i] = (f32x4){0.f, 0.f, 0.f, 0.f};
#define HG_LOAD(NC) do { const int n_ = (NC); const bool ic_ = n_ < 4; const int nn_ = ic_ ? n_ : n_ - 4; \
        _Pragma("unroll") for (int st = 0; st < 4; ++st) { const int pos = 64 * nn_ + 4 * sg + st; \
            if (ic_) { const int tk = dir ? (CTXL - 1 - pos) : pos; const bf16_t* rp = Pc + (size_t)(b * CTXL + tk) * PCW; \
                kraw[st] = *(const u32x2*)(rp + 512 + dir * 512 + head * 128 + 4 * cgi); qraw[st] = (u32x2){0u, 0u}; } \
            else { const int tk = dir ? (SEQ - 1 - pos) : pos; const bf16_t* rp = P + (size_t)(b * SEQ + tk) * PW; \
                kraw[st] = *(const u32x2*)(rp + 1024 + dir * 512 + head * 128 + 4 * cgi); qraw[st] = *(const u32x2*)(rp + head * 128 + 4 * cgi); } } \
        _Pragma("unroll") for (int e = 0; e < 2; ++e) { const int pos = 64 * nn_ + 2 * sp + e; \
            if (ic_) { const int tk = dir ? (CTXL - 1 - pos) : pos; vraw[e] = *(const u32x4*)(Pc + (size_t)(b * CTXL + tk) * PCW + head * 128 + 8 * vg); } \
            else { const int tk = dir ? (SEQ - 1 - pos) : pos; vraw[e] = *(const u32x4*)(P + (size_t)(b * SEQ + tk) * PW + 512 + head * 128 + 8 * vg); } } } while (0)
    u32x2 kraw[4], qraw[4]; u32x4 vraw[2];
    HG_LOAD(0);
    for (int n = 0; n < 36; ++n) {
        const bool isctx = n < 4; const int nn = isctx ? n : n - 4;
        f32x4 kv[4], El[4];
#pragma unroll
        for (int st = 0; st < 4; ++st) {
            kv[st] = (f32x4){hlo(kraw[st].x), hhi(kraw[st].x), hlo(kraw[st].y), hhi(kraw[st].y)};
            const f32x4 f = 1.0f - kv[st];
            El[st] = (st == 0) ? f : El[st - 1] * f;
        }
        *(LAS f32x4*)(lds + HTOT + (sg * 128 + 4 * cgi) * 4) = El[3];
        __syncthreads();
        f32x4 pre = (f32x4){1.f, 1.f, 1.f, 1.f}, mypre = pre, emid = pre;
#pragma unroll
        for (int s2 = 0; s2 < 16; ++s2) {
            const f32x4 tv = *(const LAS f32x4*)(lds + HTOT + (s2 * 128 + 4 * cgi) * 4);
            if (s2 == sg) mypre = pre;
            pre *= tv;
            if (s2 == 7) emid = pre;
        }
        const f32x4 elast = pre;
        f32x4 remid; remid[0] = __frcp_rn(emid[0]); remid[1] = __frcp_rn(emid[1]); remid[2] = __frcp_rn(emid[2]); remid[3] = __frcp_rn(emid[3]);
        f32x4 kh[4], Rv[4];
        { const f32x4 E3 = mypre * El[3];
          Rv[3][0] = __builtin_amdgcn_rcpf(E3[0]); Rv[3][1] = __builtin_amdgcn_rcpf(E3[1]); Rv[3][2] = __builtin_amdgcn_rcpf(E3[2]); Rv[3][3] = __builtin_amdgcn_rcpf(E3[3]);
          Rv[2] = Rv[3] * (1.0f - kv[3]); Rv[1] = Rv[2] * (1.0f - kv[2]); Rv[0] = Rv[1] * (1.0f - kv[1]); }
#pragma unroll
        for (int st = 0; st < 4; ++st) {
            const f32x4 E = mypre * El[st];
            const f32x4 R = Rv[st];
            const f32x4 kr = kv[st] * R;
            kh[st] = kr * elast;
            if (!isctx) {
                const f32x4 qv = (f32x4){bflo(qraw[st].x), bfhi(qraw[st].x), bflo(qraw[st].y), bfhi(qraw[st].y)};
                const f32x4 qe = qv * E, q1 = qe * remid, k1 = kr * emid;
                const int off = (4 * sg + st) * HP + 8 * cgi;
                *(LAS u32x2*)(lds + HQH + off) = (u32x2){pk2(qe[0], qe[1]), pk2(qe[2], qe[3])};
                *(LAS u32x2*)(lds + HQ1 + off) = (u32x2){pk2(q1[0], q1[1]), pk2(q1[2], q1[3])};
                *(LAS u32x2*)(lds + HK1 + off) = (u32x2){pk2(k1[0], k1[1]), pk2(k1[2], k1[3])};
            }
        }
#pragma unroll
        for (int i = 0; i < 4; ++i) {
            const int ch = 4 * cgi + i;
            *(LAS u32x2*)(lds + HKT + swz128(ch, 4 * sg)) = (u32x2){pk2(kh[0][i], kh[1][i]), pk2(kh[2][i], kh[3][i])};
        }
        if (sg == 0) *(LAS f32x4*)(lds + HEL + 16 * cgi) = elast;
        {
            const unsigned a[4] = {vraw[0].x, vraw[0].y, vraw[0].z, vraw[0].w}, c2[4] = {vraw[1].x, vraw[1].y, vraw[1].z, vraw[1].w};
#pragma unroll
            for (int i = 0; i < 4; ++i) {
                const unsigned lo = (a[i] & 0xffffu) | (c2[i] << 16), hi = (a[i] >> 16) | (c2[i] & 0xffff0000u);
                *(LAS unsigned*)(lds + HVT + swz128(8 * vg + 2 * i, 2 * sp)) = lo;
                *(LAS unsigned*)(lds + HVT + swz128(8 * vg + 2 * i + 1, 2 * sp)) = hi;
            }
        }
        if (n + 1 < 36) HG_LOAD(n + 1);
        __syncthreads();
        f32x4 O[4];
#pragma unroll
        for (int i = 0; i < 4; ++i) O[i] = (f32x4){0.f, 0.f, 0.f, 0.f};
        if (!isctx) {
#pragma unroll
            for (int tt = 0; tt < 2; ++tt) {
                const int tl = 2 * w + tt, st_ = tl >> 2, ct = tl & 3;
                f32x4 c4 = (f32x4){0.f, 0.f, 0.f, 0.f};
                if (st_ <= ct) {
#pragma unroll
                    for (int ks = 0; ks < 4; ++ks) {
                        const bf16x8 a = *(const LAS bf16x8*)(lds + HK1 + (16 * st_ + l15) * HP + (32 * ks + 8 * q4) * 2);
                        const bf16x8 bb = *(const LAS bf16x8*)(lds + HQ1 + (16 * ct + l15) * HP + (32 * ks + 8 * q4) * 2);
                        c4 = __builtin_amdgcn_mfma_f32_16x16x32_bf16(a, bb, c4, 0, 0, 0);
                    }
                    const int cc = 16 * ct + l15, s0 = 16 * st_ + 4 * q4;
#pragma unroll
                    for (int j = 0; j < 4; ++j) if (s0 + j > cc) c4[j] = 0.f;
                }
                *(LAS u32x2*)(lds + HAI + (16 * ct + l15) * 144 + (16 * st_ + 4 * q4) * 2) = (u32x2){pk2(c4[0], c4[1]), pk2(c4[2], c4[3])};
            }
#pragma unroll
            for (int ks = 0; ks < 4; ++ks) {
                const f32x4 s0 = S[2 * ks], s1 = S[2 * ks + 1];
                const bf16x8 a = __builtin_bit_cast(bf16x8, (u32x4){pk2(s0[0], s0[1]), pk2(s0[2], s0[3]), pk2(s1[0], s1[1]), pk2(s1[2], s1[3])});
#pragma unroll
                for (int ct = 0; ct < 4; ++ct) {
                    LAS unsigned char* qp = lds + HQH + (16 * ct + l15) * HP + (32 * ks + 4 * q4) * 2;
                    const u32x2 lo = *(const LAS u32x2*)qp, hi = *(const LAS u32x2*)(qp + 32);
                    const bf16x8 bb = __builtin_bit_cast(bf16x8, (u32x4){lo.x, lo.y, hi.x, hi.y});
                    O[ct] = __builtin_amdgcn_mfma_f32_16x16x32_bf16(a, bb, O[ct], 0, 0, 0);
                }
            }
            __syncthreads();
#pragma unroll
            for (int ks = 0; ks < 2; ++ks) {
                const bf16x8 a = *(const LAS bf16x8*)(lds + HVT + swz128(16 * w + l15, 32 * ks + 8 * q4));
#pragma unroll
                for (int ct = 0; ct < 4; ++ct) {
                    const bf16x8 bb = *(const LAS bf16x8*)(lds + HAI + (16 * ct + l15) * 144 + (32 * ks + 8 * q4) * 2);
                    O[ct] = __builtin_amdgcn_mfma_f32_16x16x32_bf16(a, bb, O[ct], 0, 0, 0);
                }
            }
#pragma unroll
            for (int ct = 0; ct < 4; ++ct) {
                const int pos = 64 * nn + 16 * ct + l15; const int tk = dir ? (SEQ - 1 - pos) : pos;
                *(u32x2*)(Oout + (size_t)(b * SEQ + tk) * 512 + head * 128 + 16 * w + 4 * q4) = (u32x2){pk2(O[ct][0], O[ct][1]), pk2(O[ct][2], O[ct][3])};
            }
        }
        {
            bf16x8 vb2[2];
#pragma unroll
            for (int ks = 0; ks < 2; ++ks) vb2[ks] = *(const LAS bf16x8*)(lds + HVT + swz128(16 * w + l15, 32 * ks + 8 * q4));
#pragma unroll
            for (int cht = 0; cht < 8; ++cht) {
                const f32x4 el = *(const LAS f32x4*)(lds + HEL + (16 * cht + 4 * q4) * 4);
                S[cht] *= el;
#pragma unroll
                for (int ks = 0; ks < 2; ++ks) {
                    const bf16x8 a = *(const LAS bf16x8*)(lds + HKT + swz128(16 * cht + l15, 32 * ks + 8 * q4));
                    S[cht] = __builtin_amdgcn_mfma_f32_16x16x32_bf16(a, vb2[ks], S[cht], 0, 0, 0);
                }
            }
        }
    }
    __syncthreads();
}

__device__ __forceinline__ void hg_out_pass(const bf16_t* __restrict__ OHF, const bf16_t* __restrict__ OHB, const bf16_t* __restrict__ P, const float* __restrict__ hgain, bf16_t* __restrict__ OM) {
    const int tid_ = opaque_tid(); const int lane = tid_ & 63, wave = tid_ >> 6;
    float gn[8];
#pragma unroll
    for (int e = 0; e < 8; ++e) gn[e] = hgain[(lane & 15) * 8 + e];
    const int W = (int)gridDim.x * 8, gw = (int)blockIdx.x * 8 + wave;
    const int rpw = (TL + W - 1) / W;
    const int r0 = gw * rpw, r1 = (r0 + rpw < TL) ? r0 + rpw : TL;
    if (r0 < r1) {
        u32x4 a = *(const u32x4*)(OHF + (size_t)r0 * 512 + lane * 8), c = *(const u32x4*)(OHB + (size_t)r0 * 512 + lane * 8), gt = *(const u32x4*)(P + (size_t)r0 * PW + 2048 + lane * 8);
        for (int r = r0; r < r1; ++r) {
            u32x4 an = a, cn = c, gtn = gt;
            if (r + 1 < r1) { an = *(const u32x4*)(OHF + (size_t)(r + 1) * 512 + lane * 8); cn = *(const u32x4*)(OHB + (size_t)(r + 1) * 512 + lane * 8); gtn = *(const u32x4*)(P + (size_t)(r + 1) * PW + 2048 + lane * 8); }
            float v[8] = {bflo(a.x) + bflo(c.x), bfhi(a.x) + bfhi(c.x), bflo(a.y) + bflo(c.y), bfhi(a.y) + bfhi(c.y), bflo(a.z) + bflo(c.z), bfhi(a.z) + bfhi(c.z), bflo(a.w) + bflo(c.w), bfhi(a.w) + bfhi(c.w)};
            float ss = 0.f;
#pragma unroll
            for (int e = 0; e < 8; ++e) ss += v[e] * v[e];
            ss += __shfl_xor(ss, 1); ss += __shfl_xor(ss, 2); ss += __shfl_xor(ss, 4); ss += __shfl_xor(ss, 8);
            const float rstd = rsqrtf(ss * (1.0f / 128.0f) + EPS);
            const float gg[8] = {bflo(gt.x), bfhi(gt.x), bflo(gt.y), bfhi(gt.y), bflo(gt.z), bfhi(gt.z), bflo(gt.w), bfhi(gt.w)};
#pragma unroll
            for (int e = 0; e < 8; ++e) v[e] = v[e] * rstd * gn[e] * gg[e];
            u32x4 wv; wv.x = pk2(v[0], v[1]); wv.y = pk2(v[2], v[3]); wv.z = pk2(v[4], v[5]); wv.w = pk2(v[6], v[7]);
            *(u32x4*)(OM + (size_t)r * 1024 + 512 + lane * 8) = wv;
            a = an; c = cn; gt = gtn;
        }
    }
}

#define XB_TMO      128
#define XB_XCNT(j)  (256  + 64 * (j))
#define XB_XCNT(j)  (256  + 64 * (j))
#define XB_XSUB(j)  (1280 + 64 * (j))
#define XB_XGEN(j)  (2304 + 64 * (j))
#define XB_TOP      3328
#define XB_TOPGEN   3392
#define XCD_BAR_WORDS 3456
#define XB_SPIN_CAP (1u << 18)

__device__ __forceinline__ unsigned xb_ld(unsigned* p)              { return __hip_atomic_load(p, __ATOMIC_RELAXED, __HIP_MEMORY_SCOPE_AGENT); }
__device__ __forceinline__ unsigned xb_add(unsigned* p, unsigned v) { return __hip_atomic_fetch_add(p, v, __ATOMIC_RELAXED, __HIP_MEMORY_SCOPE_AGENT); }
__device__ __forceinline__ unsigned xb_xcc_id() { return (unsigned)__builtin_amdgcn_s_getreg((3 << 11) | 20) & 0xFu; }
#define XB_SPIN(cond, bar) do { unsigned _sp = 0; while (cond) { __builtin_amdgcn_s_sleep(1); \
    if ((++_sp & 255u) == 0u) { if (xb_ld(&(bar)[XB_TMO])) break; if (_sp > XB_SPIN_CAP) { atomicAdd(&(bar)[XB_TMO], 1u); break; } } } } while (0)

struct XcdBarrier {
    unsigned* bar; unsigned x;
    volatile LAS unsigned* st;
};

__device__ __forceinline__ XcdBarrier xcd_barrier_post(unsigned* bar, volatile LAS unsigned* st) {
    XcdBarrier b; b.bar = bar; b.x = xb_xcc_id(); b.st = st;
    if (threadIdx.x == 0) (void)xb_add(&bar[XB_XCNT(b.x)], 1u);
    return b;
}
__device__ __forceinline__ void xcd_barrier_complete(unsigned* bar, unsigned x, unsigned& nloc, unsigned& nx) {
    const unsigned G = gridDim.x * gridDim.y * gridDim.z;
    unsigned sum, cnt, mine, sp = 0u;
    for (;;) {
        sum = 0u; cnt = 0u; mine = 0u;
#pragma unroll
        for (unsigned j = 0; j < 16; ++j) { const unsigned c = xb_ld(&bar[XB_XCNT(j)]); sum += c; cnt += (c > 0u) ? 1u : 0u; mine = (j == x) ? c : mine; }
        if (sum == G) break;
        __builtin_amdgcn_s_sleep(1);
        if ((++sp & 255u) == 0u) { if (xb_ld(&bar[XB_TMO])) break; if (sp > XB_SPIN_CAP) { atomicAdd(&bar[XB_TMO], 1u); break; } }
    }
    nloc = mine > 0u ? mine : 1u; nx = cnt > 0u ? cnt : 1u;
}

__device__ __forceinline__ void xcd_barrier(const XcdBarrier& b) {
    asm volatile("s_waitcnt vmcnt(0)" ::: "memory");
    __syncthreads();
    if (threadIdx.x == 0) {
        unsigned* bar = b.bar;
        __builtin_amdgcn_s_waitcnt(0);
        unsigned nloc = b.st[0], nx = b.st[1];
        if (nloc == 0u) { xcd_barrier_complete(bar, b.x, nloc, nx); b.st[0] = nloc; b.st[1] = nx; }
        const unsigned old = xb_add(&bar[XB_XSUB(b.x)], 1u);
        const unsigned gen = old / nloc;
        if (old + 1u == (gen + 1u) * nloc) {
            __builtin_amdgcn_fence(__ATOMIC_RELEASE, "agent");
            asm volatile("s_waitcnt vmcnt(0)" ::: "memory");
            const unsigned og = xb_add(&bar[XB_TOP], 1u);
            const unsigned tg = og / nx;
            if (og + 1u == (tg + 1u) * nx) xb_add(&bar[XB_TOPGEN], 1u);
            else XB_SPIN(xb_ld(&bar[XB_TOPGEN]) == tg, bar);
            __builtin_amdgcn_fence(__ATOMIC_ACQUIRE, "agent");
            xb_add(&bar[XB_XGEN(b.x)], 1u);
            asm volatile("s_waitcnt vmcnt(0)" ::: "memory");
        } else {
            XB_SPIN(xb_ld(&bar[XB_XGEN(b.x)]) == gen, bar);
            __builtin_amdgcn_fence(__ATOMIC_ACQUIRE, "agent");
            asm volatile("s_waitcnt vmcnt(0)" ::: "memory");
        }
    }
    __syncthreads();
}


#define grid_sync_all(gb) xcd_barrier(gb)

__global__ void __launch_bounds__(NTHREADS, 2) fwd_megakernel(Params p) {
    extern __shared__ __attribute__((aligned(16))) unsigned char lds_raw[];
    LAS unsigned char* lds = (LAS unsigned char*)lds_raw;
    cg::grid_group grid = cg::this_grid();
    { volatile LAS unsigned* st0 = (volatile LAS unsigned*)(lds + MISC_OFF + 32); if (threadIdx.x < 2) st0[threadIdx.x] = 0u; }
    __syncthreads();
    XcdBarrier gb = xcd_barrier_post((unsigned*)(p.ws + WS_CTL + 1024), (volatile LAS unsigned*)(lds + MISC_OFF + 32));
    const int G = (int)gridDim.x, bx = (int)blockIdx.x;
    unsigned char* ws = p.ws;
    const float* x = p.in[0]; const float* ctx = p.in[2];
    const float* npre = p.in[6]; const float* npost = p.in[7];
    float* mod = (float*)(ws + WS_MOD);
    bf16_t* U = (bf16_t*)(ws + WS_U); bf16_t* H = (bf16_t*)(ws + WS_BIG); bf16_t* Y = (bf16_t*)(ws + WS_Y); bf16_t* P = (bf16_t*)(ws + WS_BIG);
    bf16_t* Pc = (bf16_t*)(ws + WS_FW); bf16_t* QO = (bf16_t*)(ws + WS_Q); bf16_t* Kn = (bf16_t*)(ws + WS_K); bf16_t* Vt = (bf16_t*)(ws + WS_VT);
    bf16_t* OHF = (bf16_t*)(ws + WS_OHF); bf16_t* OHB = (bf16_t*)(ws + WS_OHB);
    bf16_t* X1B = (bf16_t*)p.out;
    bf16_t* X2B = OHF;
    bf16_t* OM = U;
    bf16_t* YB = OHF;
    float* out = p.out;

    p0_prep(p, lds);
    asm volatile("s_waitcnt vmcnt(0) lgkmcnt(0)" ::: "memory");
    grid.sync();
    if (threadIdx.x < 64) { __builtin_amdgcn_fence(__ATOMIC_ACQUIRE, "agent"); asm volatile("s_waitcnt vmcnt(0)" ::: "memory"); }
    __syncthreads();
    norm_pass(nullptr, x, ctx, nullptr, mod, nullptr, 0, 0.f, nullptr, nullptr, npre + 0 * D, 0, 1, U, TT);
    grid_sync_all(gb);
    { pg8::Gemm g{U, (const bf16_t*)(ws + WS_FW), TT, 2 * DFF, D}; pg8::StaticOrder S; S.init(TT, 2 * DFF, G, bx);
      EpiSwiGLU E{H}; pg8::gemm_phase<EpiSwiGLU, pg8::StaticOrder, true, true>(lds, g, S, E); }
    grid_sync_all(gb);
    { pg8::Gemm g{H, (const bf16_t*)(ws + WS_FW + 11534336), TT, D, DFF}; pg8::StaticOrder S; S.init(TT, D, G, bx);
      EpiStore E{Y, D}; pg8::gemm_phase<EpiStore, pg8::StaticOrder, true, true>(lds, g, S, E); }
    grid_sync_all(gb);
    norm_pass(Y, x, ctx, nullptr, mod, npost + 0 * D, 2, 0.5f, nullptr, X1B, npre + 1 * D, 3, 4, U, TT);
    grid_sync_all(gb);
    { pg8::Gemm g{U, (const bf16_t*)(ws + WS_WIN), TT, DIN, D}; InOrder S; S.init(G, bx);
      EpiIn E{P, Pc, QO, Kn, Vt, p.in[12], p.in[13], (const float*)(ws + WS_LB), (const float*)(ws + WS_ROPE)};
      pg8::gemm_phase<EpiIn, InOrder, true, true>(lds, g, S, E); }
    grid_sync_all(gb);
    {
        for (int it = bx; it < 128; it += G) hgrn_item(it, P, Pc, OHF, OHB, lds);
        unsigned* ctl = (unsigned*)(ws + WS_CTL);
        const float att_cb = ((const float*)(ws + WS_ROPE))[2048]; const bool att_bounded = att_cb <= 30.0f;
        volatile LAS unsigned* bc = (volatile LAS unsigned*)(lds + MISC_OFF);
        for (;;) {
            __syncthreads();
            if (threadIdx.x == 0) bc[0] = atomicAdd(ctl, 1u);
            __syncthreads();
            const unsigned unit = bc[0];
            if (unit >= 1024u) break;
            if (att_bounded) attn_unit<true>((int)unit, att_cb, Kn, Vt, QO, OM, lds); else attn_unit<false>((int)unit, 0.f, Kn, Vt, QO, OM, lds);
        }
    }
    grid_sync_all(gb);
    hg_out_pass(OHF, OHB, P, p.in[15], OM);
    grid_sync_all(gb);
    { pg8::Gemm g{OM, (const bf16_t*)(ws + WS_WAO), TL, D, D}; pg8::StaticOrder S; S.init(TL, D, G, bx);
      EpiMerge2 E{YB, P}; pg8::gemm_phase<EpiMerge2, pg8::StaticOrder, true, true>(lds, g, S, E); }
    grid_sync_all(gb);
    { pg8::Gemm g{YB, (const bf16_t*)(ws + WS_WO), TL, D, D}; pg8::StaticOrder S; S.init(TL, D, G, bx);
      EpiStore E{Y, D}; pg8::gemm_phase<EpiStore, pg8::StaticOrder, true, true>(lds, g, S, E); }
    transpose_jobs(p, 1, 3, (LAS float*)lds);
    grid_sync_all(gb);
    norm_pass(Y, nullptr, nullptr, X1B, mod, npost + 1 * D, 5, 1.0f, nullptr, X2B, npre + 2 * D, 6, 7, U, TL);
    grid_sync_all(gb);
    { pg8::Gemm g{U, (const bf16_t*)(ws + WS_Q), TL, 2 * DFF, D}; pg8::StaticOrder S; S.init(TL, 2 * DFF, G, bx);
      EpiSwiGLU E{H}; pg8::gemm_phase<EpiSwiGLU, pg8::StaticOrder, true, true>(lds, g, S, E); }
    grid_sync_all(gb);
    { pg8::Gemm g{H, (const bf16_t*)(ws + WS_Q + 11534336), TL, D, DFF}; pg8::StaticOrder S; S.init(TL, D, G, bx);
      EpiStore E{Y, D}; pg8::gemm_phase<EpiStore, pg8::StaticOrder, true, true>(lds, g, S, E); }
    grid_sync_all(gb);
    norm_pass(Y, nullptr, nullptr, X2B, mod, npost + 2 * D, 8, 0.5f, out, nullptr, nullptr, 0, 0, nullptr, TL);
}

extern "C" void kernel_launch(void* const* d_in, const int* in_sizes, int n_in, void* d_out, int out_size, void* d_ws, size_t ws_size, hipStream_t stream) {
    static int grid_blocks = 0;
    if (grid_blocks == 0) {
        int dev = 0, cus = 0, per_cu = 0;
        hipGetDevice(&dev);
        hipDeviceGetAttribute(&cus, hipDeviceAttributeMultiprocessorCount, dev);
        hipFuncSetAttribute((const void*)fwd_megakernel, hipFuncAttributeMaxDynamicSharedMemorySize, LDS_BYTES);
        hipOccupancyMaxActiveBlocksPerMultiprocessor(&per_cu, (const void*)fwd_megakernel, NTHREADS, LDS_BYTES);
        if (per_cu < 1) per_cu = 1;
        if (per_cu > 1) per_cu = 1;
        grid_blocks = cus * per_cu;
        if (ws_size < WS_END) fprintf(stderr, "kernel_launch: workspace too small: %zu < %zu\n", ws_size, (size_t)WS_END);
        (void)hipGetLastError();
    }
    (void)hipMemsetAsync((unsigned char*)d_ws + WS_CTL, 0, 16384, stream);
    Params p{};
    for (int i = 0; i < 19; ++i) p.in[i] = (const float*)d_in[i];
    p.out = (float*)d_out; p.ws = (unsigned char*)d_ws;
    void* args[] = {&p};
    hipError_t e = hipLaunchCooperativeKernel((const void*)fwd_megakernel, dim3(grid_blocks), dim3(NTHREADS), args, LDS_BYTES, stream);
    if (e != hipSuccess) fprintf(stderr, "cooperative launch failed: %s (grid %d)\n", hipGetErrorString(e), grid_blocks);
}
```

```cpp
#include <hip/hip_runtime.h>
#include <hip/hip_cooperative_groups.h>
#include <cstdio>
#include <cstdint>
namespace cg = cooperative_groups;
__device__ __forceinline__ int opaque_tid() { int t; asm volatile("v_mov_b32 %0, %1" : "=v"(t) : "v"((int)threadIdx.x)); return t; }
namespace pg8 {
#define PG8_LAS __attribute__((address_space(3)))
typedef unsigned short bf16_t;
typedef short bf16x8 __attribute__((ext_vector_type(8)));
typedef float f32x4 __attribute__((ext_vector_type(4)));
typedef unsigned u32x4 __attribute__((ext_vector_type(4)));
constexpr int BM = 256, BK = 64, HALF = 128, HTB = HALF * BK * 2  , STAGE_BYTES = 8 * HTB, NXCD = 8, WGM = 8;

__host__ __device__ __forceinline__ int lds_byte(int r, int c) { const int st = (r >> 4) * 2 + (c >> 5), rr = r & 15, cc = c & 31, ob = rr * 64 + cc * 2; return st * 1024 + (ob ^ (((ob >> 9) & 1) << 5)); }
__host__ __device__ __forceinline__ void stage_rc(int b, int& R, int& C) { const int st = b / 1024, sb = b % 1024, swz = sb ^ (((sb >> 9) & 1) << 5); R = (st >> 1) * 16 + swz / 64; C = (st & 1) * 32 + (swz % 64) / 2; }
__host__ __device__ __forceinline__ int perm32(int rho) { const int n = rho >> 4, i = rho & 15; return 8 * (i >> 2) + 4 * n + (i & 3); }

struct Unit { int pm, pn; };
struct Gemm { const bf16_t* A; const bf16_t* Bt; int M, N, K; };

struct StaticOrder {
    int nM, nN, nwg, G, c;
    __host__ __device__ void init(int M, int N, int G_, int c_) { nM = M / BM; nN = N / BM; nwg = nM * nN; G = G_; c = c_; }
    __host__ __device__ bool next(int i, Unit& u) const {
        const long L = (long)i * G + c; if (L >= nwg) return false;
        int wgid = (int)L; { const int q = nwg / NXCD, r = nwg % NXCD, xcd = wgid % NXCD, off = wgid / NXCD; wgid = (xcd < r ? xcd * (q + 1) : r * (q + 1) + (xcd - r) * q) + off; }
        const int nig = WGM * nN, gid = wgid / nig, fm = gid * WGM, gsz = (nM - fm) < WGM ? (nM - fm) : WGM;
        u.pm = fm + ((wgid % nig) % gsz); u.pn = (wgid % nig) / gsz; return true;
    }
    __device__ __forceinline__ void a_ready(const Unit&) const {}
    __device__ __forceinline__ void done(const Unit&) const {}
};

__device__ __forceinline__ unsigned cvt_pk_bf16(float lo, float hi) { unsigned r; asm volatile("v_cvt_pk_bf16_f32 %0, %1, %2" : "=v"(r) : "v"(lo), "v"(hi)); return r; }
template <class Epi, class Sched, bool ALIGN_EPI = false, bool SP2 = false>
__device__ __forceinline__ void gemm_phase(PG8_LAS unsigned char* lds, const Gemm g, const Sched& S, const Epi& E) {
    const int tid = opaque_tid(), wid = __builtin_amdgcn_readfirstlane(tid >> 6), lane = tid & 63, wr = wid >> 2, wc = wid & 3, fr = lane & 15, fq = lane >> 4;
    const int K = g.K, nt = K / BK;
    unsigned voffA[2], voffB[2];
#pragma unroll
    for (int i = 0; i < 2; ++i) { int R, C; stage_rc(tid * 16 + i * 8192, R, C); const int Rb = Epi::PERM ? ((R & ~31) + perm32(R & 31)) : R;
        voffA[i] = (unsigned)(R * K + C) * 2u; voffB[i] = (unsigned)(Rb * K + C) * 2u; }
    const size_t kstep = (size_t)(BK * 2);
    const size_t hstep = (size_t)HALF * K * 2;
    const size_t tstep = 2 * hstep;
    const unsigned ldsw = (unsigned)wid * 1024u;
    const int aoff = lds_byte(wr * 64 + fr, fq * 8), boff = lds_byte(wc * 32 + fr, fq * 8);
#define PG8_SA(b, h) (((b) * 2 + (h)) * HTB)
#define PG8_SB(b, h) ((4 + (b) * 2 + (h)) * HTB)
#define PG8_STAGE(bufoff, gbase, voff) do { _Pragma("unroll") for (int _i = 0; _i < 2; ++_i) \
        __builtin_amdgcn_global_load_lds((const unsigned*)((const char*)(gbase) + (voff)[_i]), (PG8_LAS unsigned*)(lds + (bufoff) + ldsw + _i * 8192), 16, 0, 0); } while (0)
#define PG8_LDA(dst, b, h) do { _Pragma("unroll") for (int m = 0; m < 4; ++m) _Pragma("unroll") for (int k = 0; k < 2; ++k) dst[m][k] = *(const PG8_LAS bf16x8*)(lds + PG8_SA(b, h) + aoff + m * 2048 + k * 1024); } while (0)
#define PG8_LDB(dst, b, h) do { _Pragma("unroll") for (int n = 0; n < 2; ++n) _Pragma("unroll") for (int k = 0; k < 2; ++k) dst[n][k] = *(const PG8_LAS bf16x8*)(lds + PG8_SB(b, h) + boff + n * 2048 + k * 1024); } while (0)
#define PG8_MMA(ai, bj, At, Bt) do { __builtin_amdgcn_s_setprio(1); _Pragma("unroll") for (int m = 0; m < 4; ++m) _Pragma("unroll") for (int n = 0; n < 2; ++n) _Pragma("unroll") for (int k = 0; k < 2; ++k) \
        acc[ai][bj][m][n] = __builtin_amdgcn_mfma_f32_16x16x32_bf16(Bt[n][k], At[m][k], acc[ai][bj][m][n], 0, 0, 0); __builtin_amdgcn_s_setprio(0); } while (0)
#define PG8_WAIT_V(n) asm volatile("s_waitcnt vmcnt(" #n ")" ::: "memory")
#define PG8_WAIT_L(n) asm volatile("s_waitcnt lgkmcnt(" #n ")" ::: "memory")
#define PG8_BAR __builtin_amdgcn_s_barrier()
#define PG8_SCHED __builtin_amdgcn_sched_barrier(0)
    Unit cur, nxt; int ui = 0;
    if (!S.next(0, cur)) return;
    f32x4 acc[2][2][4][2];
#pragma unroll
    for (int a = 0; a < 2; ++a)
#pragma unroll
        for (int b = 0; b < 2; ++b)
#pragma unroll
            for (int m = 0; m < 4; ++m)
#pragma unroll
                for (int n = 0; n < 2; ++n) acc[a][b][m][n] = (f32x4){0.f, 0.f, 0.f, 0.f};
    bf16x8 At[4][2], B0[2][2], B1[2][2];
    const char* cA = (const char*)g.A + (size_t)cur.pm * tstep; const char* cB = (const char*)g.Bt + (size_t)cur.pn * tstep;
    S.a_ready(cur);
    if constexpr (SP2) {
        PG8_STAGE(PG8_SB(0, 0), cB, voffB); PG8_STAGE(PG8_SB(0, 1), cB + hstep, voffB); PG8_STAGE(PG8_SA(0, 0), cA, voffA); PG8_STAGE(PG8_SA(0, 1), cA + hstep, voffA);
        if (wr == 1) PG8_BAR;
        PG8_WAIT_V(2); PG8_BAR;
        PG8_STAGE(PG8_SB(1, 0), cB + kstep, voffB); PG8_STAGE(PG8_SA(1, 0), cA + kstep, voffA); PG8_STAGE(PG8_SB(1, 1), cB + hstep + kstep, voffB);
        PG8_WAIT_V(6); PG8_BAR;
    } else {
        PG8_STAGE(PG8_SB(0, 0), cB, voffB); PG8_STAGE(PG8_SA(0, 0), cA, voffA); PG8_STAGE(PG8_SB(0, 1), cB + hstep, voffB); PG8_STAGE(PG8_SA(0, 1), cA + hstep, voffA);
        if (wr == 1) PG8_BAR;
        PG8_WAIT_V(4); PG8_BAR;
        PG8_STAGE(PG8_SB(1, 0), cB + kstep, voffB); PG8_STAGE(PG8_SA(1, 0), cA + kstep, voffA); PG8_STAGE(PG8_SB(1, 1), cB + hstep + kstep, voffB);
        PG8_WAIT_V(6); PG8_BAR;
    }
    for (;;) {
        const bool has_next = S.next(ui + 1, nxt);
        const char* nA = has_next ? (const char*)g.A + (size_t)nxt.pm * tstep : cA; const char* nB = has_next ? (const char*)g.Bt + (size_t)nxt.pn * tstep : cB;
        for (int t = 0; t < nt; t += 2) {
            const bool last = (t == nt - 2);
            if constexpr (Epi::HAS_MID) { if (t == (nt >> 1)) E.mid(acc, cur, wr, wc, fr, fq); }
            const char* a1 = cA + (size_t)(t + 1) * kstep;
            const char* a2 = last ? nA : cA + (size_t)(t + 2) * kstep; const char* b2 = last ? nB : cB + (size_t)(t + 2) * kstep;
            const char* a3 = a2 + kstep; const char* b3 = b2 + kstep;
            if (last && has_next) S.a_ready(nxt);
            if constexpr (SP2) {
            PG8_LDB(B0, 0, 0); PG8_LDB(B1, 0, 1); PG8_SCHED; PG8_LDA(At, 0, 0); PG8_STAGE(PG8_SA(1, 1), a1 + hstep, voffA);
            PG8_WAIT_V(8); PG8_WAIT_L(0); PG8_BAR; PG8_MMA(0, 0, At, B0); PG8_MMA(0, 1, At, B1); PG8_BAR; PG8_SCHED;
            PG8_LDA(At, 0, 1); PG8_STAGE(PG8_SB(0, 0), b2, voffB); PG8_STAGE(PG8_SB(0, 1), b2 + hstep, voffB); PG8_STAGE(PG8_SA(0, 0), a2, voffA);
            PG8_WAIT_V(8); PG8_WAIT_L(0); PG8_BAR; PG8_MMA(1, 0, At, B0); PG8_MMA(1, 1, At, B1); PG8_BAR; PG8_SCHED;
            PG8_LDB(B0, 1, 0); PG8_LDB(B1, 1, 1); PG8_SCHED; PG8_LDA(At, 1, 0); PG8_STAGE(PG8_SA(0, 1), a2 + hstep, voffA);
            PG8_WAIT_V(8); PG8_WAIT_L(0); PG8_BAR; PG8_MMA(0, 0, At, B0); PG8_MMA(0, 1, At, B1); PG8_BAR; PG8_SCHED;
            PG8_LDA(At, 1, 1); PG8_STAGE(PG8_SB(1, 0), b3, voffB); PG8_STAGE(PG8_SB(1, 1), b3 + hstep, voffB); PG8_STAGE(PG8_SA(1, 0), a3, voffA);
            PG8_WAIT_V(8); PG8_WAIT_L(0); PG8_BAR; PG8_MMA(1, 0, At, B0); PG8_MMA(1, 1, At, B1); PG8_BAR; PG8_SCHED;
            } else {
            PG8_LDB(B0, 0, 0); PG8_SCHED; PG8_LDA(At, 0, 0); PG8_STAGE(PG8_SA(1, 1), a1 + hstep, voffA);
            PG8_WAIT_L(8); PG8_BAR; PG8_WAIT_L(0); PG8_MMA(0, 0, At, B0); PG8_BAR; PG8_SCHED;
            PG8_LDB(B1, 0, 1); PG8_STAGE(PG8_SB(0, 0), b2, voffB);
            PG8_BAR; PG8_WAIT_L(0); PG8_MMA(0, 1, At, B1); PG8_BAR;
            PG8_LDA(At, 0, 1); PG8_STAGE(PG8_SA(0, 0), a2, voffA);
            PG8_BAR; PG8_WAIT_L(0); PG8_MMA(1, 0, At, B0); PG8_BAR; PG8_SCHED;
            PG8_STAGE(PG8_SB(0, 1), b2 + hstep, voffB);
            PG8_WAIT_V(6); PG8_BAR; PG8_MMA(1, 1, At, B1); PG8_BAR;
            PG8_LDB(B0, 1, 0); PG8_SCHED; PG8_LDA(At, 1, 0); PG8_STAGE(PG8_SA(0, 1), a2 + hstep, voffA);
            PG8_WAIT_L(8); PG8_BAR; PG8_WAIT_L(0); PG8_MMA(0, 0, At, B0); PG8_BAR; PG8_SCHED;
            PG8_LDB(B1, 1, 1); PG8_STAGE(PG8_SB(1, 0), b3, voffB);
            PG8_BAR; PG8_WAIT_L(0); PG8_MMA(0, 1, At, B1); PG8_BAR;
            PG8_LDA(At, 1, 1); PG8_STAGE(PG8_SA(1, 0), a3, voffA);
            PG8_BAR; PG8_WAIT_L(0); PG8_MMA(1, 0, At, B0); PG8_BAR; PG8_SCHED;
            PG8_STAGE(PG8_SB(1, 1), b3 + hstep, voffB);
            PG8_WAIT_V(6); PG8_BAR; PG8_MMA(1, 1, At, B1); PG8_BAR;
            }
        }
        if constexpr (ALIGN_EPI) { if (wr == 0) PG8_BAR; }
        if constexpr (!Epi::AFTER_DRAIN) { E(acc, cur, wr, wc, fr, fq); S.done(cur); }
        if (!has_next) break;
#pragma unroll
        for (int a = 0; a < 2; ++a)
#pragma unroll
            for (int b = 0; b < 2; ++b)
#pragma unroll
                for (int m = 0; m < 4; ++m)
#pragma unroll
                    for (int n = 0; n < 2; ++n) acc[a][b][m][n] = (f32x4){0.f, 0.f, 0.f, 0.f};
        cur = nxt; cA = nA; cB = nB; ++ui;
        if constexpr (ALIGN_EPI) { if (wr == 1) PG8_BAR; }
    }
    PG8_WAIT_V(0);
    if constexpr (!ALIGN_EPI) { if (wr == 0) PG8_BAR; }
    PG8_BAR;
    if constexpr (Epi::AFTER_DRAIN) { E.fused(acc, cur, wr, wc, fr, fq, lds, wid, lane); S.done(cur); }
#undef PG8_SA
#undef PG8_SB
#undef PG8_STAGE
#undef PG8_LDA
#undef PG8_LDB
#undef PG8_MMA
#undef PG8_WAIT_V
#undef PG8_WAIT_L
#undef PG8_BAR
#undef PG8_SCHED
}
}

#define LAS __attribute__((address_space(3)))
typedef unsigned short bf16_t;
typedef short bf16x8 __attribute__((ext_vector_type(8)));
typedef float f32x4 __attribute__((ext_vector_type(4)));
typedef float f32x16 __attribute__((ext_vector_type(16)));
typedef unsigned u32x4 __attribute__((ext_vector_type(4)));
typedef unsigned u32x2 __attribute__((ext_vector_type(2)));
using pg8::Unit;

constexpr int D = 1024, NB = 16, SEQ = 2048, CTXL = 256, TL = NB * SEQ, TC = NB * CTXL, TT = TL + TC, DFF = 2816, DIN = 5376, NMOD = 9;
constexpr int PW = 4608, PCW = 1536, NKEY = SEQ + CTXL;
constexpr float EPS = 1e-6f;
constexpr int NTHREADS = 512;
constexpr int LDS_BYTES = 131072 + 1024;
constexpr int MISC_OFF = 131072;

constexpr size_t MiB = 1048576;
constexpr size_t WS_MOD = 0;
constexpr size_t WS_LB = 768 * 1024;
constexpr size_t WS_ROPE = 800 * 1024;
constexpr size_t WS_CTL = 900 * 1024;
constexpr size_t WS_WIN = 1 * MiB;
constexpr size_t WS_WAO = WS_WIN + 11010048;
constexpr size_t WS_WHO = WS_WAO + 1 * MiB;
constexpr size_t WS_WO = WS_WHO + 1 * MiB;
constexpr size_t WS_FW = WS_WO + 2 * MiB;
constexpr size_t WS_U = 32 * MiB;
constexpr size_t WS_BIG = 104 * MiB;
constexpr size_t WS_Y = WS_BIG + 198 * MiB;
constexpr size_t WS_Q = 392 * MiB;
constexpr size_t WS_K = 424 * MiB;
constexpr size_t WS_VT = 433 * MiB;
constexpr size_t WS_OHF = 442 * MiB;
constexpr size_t WS_OHB = 474 * MiB;
constexpr size_t WS_END = 506 * MiB;
static_assert(WS_FW + 11534336 + 5767168 <= WS_U, "ws map");
static_assert(WS_WIN + 11010048 == WS_WAO, "ws map");

typedef float f32x2_t __attribute__((ext_vector_type(2)));
typedef __bf16 bf16x2_t __attribute__((ext_vector_type(2)));
__device__ __forceinline__ unsigned pk2(float lo, float hi) { const f32x2_t v = {lo, hi}; const bf16x2_t b = __builtin_convertvector(v, bf16x2_t); return __builtin_bit_cast(unsigned, b); }
__device__ __forceinline__ float bflo(unsigned u) { return __uint_as_float(u << 16); }
__device__ __forceinline__ float bfhi(unsigned u) { return __uint_as_float(u & 0xffff0000u); }
__device__ __forceinline__ float sigmoidf_(float x) { return __builtin_amdgcn_rcpf(1.0f + __builtin_amdgcn_exp2f(-1.4426950408889634f * x)); }
__device__ __forceinline__ float siluf_(float x) { return x * sigmoidf_(x); }
__device__ __forceinline__ unsigned pkh2(float lo, float hi) {
    const unsigned a = (unsigned)__builtin_bit_cast(unsigned short, (_Float16)lo), b = (unsigned)__builtin_bit_cast(unsigned short, (_Float16)hi);
    return a | (b << 16);
}
__device__ __forceinline__ float hlo(unsigned u) { return (float)__builtin_bit_cast(_Float16, (unsigned short)(u & 0xffffu)); }
__device__ __forceinline__ float hhi(unsigned u) { return (float)__builtin_bit_cast(_Float16, (unsigned short)(u >> 16)); }
__device__ __forceinline__ float wave_sum(float v) {
#pragma unroll
    for (int o = 32; o >= 1; o >>= 1) v += __shfl_xor(v, o);
    return v;
}


struct Params {
    const float* in[19];
    float* out;
    unsigned char* ws;
};

__device__ __forceinline__ int map_row(int mode, int n) {
    if (mode == 1) { if (n < 768) { const int tile = n >> 8, w = n & 255, wcq = w >> 6, rem = w & 63, bj = rem >> 5, i = rem & 31; return (tile << 8) + (bj << 7) + (wcq << 5) + i; } return n; }
    if (mode == 2) return ((n >> 7) << 8) + (n & 127);
    if (mode == 3) return ((n >> 7) << 8) + 128 + (n & 127);
    return n;
}
__device__ __forceinline__ void transpose_tile(const float* __restrict__ src, int K, int N, bf16_t* __restrict__ dst, int ld, int mode, int tk, int tn, LAS float* scr) {
    const int tid = opaque_tid();
#pragma unroll
    for (int p = 0; p < 8; ++p) { const int kr = p * 8 + (tid >> 6), nc = tid & 63; scr[nc * 65 + kr] = src[(size_t)(tk * 64 + kr) * N + tn * 64 + nc]; }
    __syncthreads();
    { const int n = tid >> 3, ch = tid & 7; const int nm = map_row(mode, tn * 64 + n);
      float v[8];
#pragma unroll
      for (int j = 0; j < 8; ++j) v[j] = scr[n * 65 + ch * 8 + j];
      u32x4 w; w.x = pk2(v[0], v[1]); w.y = pk2(v[2], v[3]); w.z = pk2(v[4], v[5]); w.w = pk2(v[6], v[7]);
      *(u32x4*)(dst + (size_t)nm * ld + tk * 64 + ch * 8) = w; }
    __syncthreads();
}
struct TJob { const float* src; int K, N; bf16_t* dst; int mode; int ld, koff; };
__device__ __forceinline__ TJob get_job(const Params& p, int set, int j) {
    unsigned char* ws = p.ws;
    if (set == 0) {
        switch (j) {
            case 0: return TJob{p.in[11], D, DIN, (bf16_t*)(ws + WS_WIN), 1, D, 0};
            case 1: return TJob{p.in[8], D, DFF, (bf16_t*)(ws + WS_FW), 2, D, 0};
            case 2: return TJob{p.in[9], D, DFF, (bf16_t*)(ws + WS_FW), 3, D, 0};
            case 3: return TJob{p.in[10], DFF, D, (bf16_t*)(ws + WS_FW + 11534336), 0, DFF, 0};
            case 4: return TJob{p.in[16], 512, D, (bf16_t*)(ws + WS_WAO), 0, 1024, 0};
            case 5: return TJob{p.in[17], 512, D, (bf16_t*)(ws + WS_WAO), 0, 1024, 512};
            default: return TJob{p.in[18], D, D, (bf16_t*)(ws + WS_WO), 0, D, 0};
        }
    }
    switch (j) {
        case 0: return TJob{p.in[8] + (size_t)D * DFF, D, DFF, (bf16_t*)(ws + WS_Q), 2, D, 0};
        case 1: return TJob{p.in[9] + (size_t)D * DFF, D, DFF, (bf16_t*)(ws + WS_Q), 3, D, 0};
        default: return TJob{p.in[10] + (size_t)D * DFF, DFF, D, (bf16_t*)(ws + WS_Q + 11534336), 0, DFF, 0};
    }
}
__device__ __forceinline__ void transpose_jobs(const Params& p, int set, int njobs, LAS float* scr) {
    int total = 0;
    for (int j = 0; j < njobs; ++j) { const TJob jb = get_job(p, set, j); total += (jb.K >> 6) * (jb.N >> 6); }
    const int G = (int)gridDim.x, bx = (int)blockIdx.x;
    const bool weighted = (set == 0) && (G > 144);
    const int nw = weighted ? 144 + 2 * (G - 144) : G;
    const int w0 = weighted ? (bx < 144 ? bx : 144 + 2 * (bx - 144)) : bx;
    const int nmine = (weighted && bx >= 144) ? 2 : 1;
    for (int k = 0; k < nmine; ++k)
    for (int t = w0 + k; t < total; t += nw) {
        int r = t, j = 0;
        for (; j < njobs - 1; ++j) { const TJob jb = get_job(p, set, j); const int c = (jb.K >> 6) * (jb.N >> 6); if (r < c) break; r -= c; }
        const TJob jb = get_job(p, set, j);
        const int ntn = jb.N >> 6;
        transpose_tile(jb.src, jb.K, jb.N, jb.dst + jb.koff, jb.ld, jb.mode, r / ntn, r % ntn, scr);
    }
}

__device__ __forceinline__ void mod_task(const Params& p, int ct, LAS float* lds) {
    const float* c = p.in[1]; const float* cctx = p.in[3]; const float* wm = p.in[4]; const float* bm = p.in[5];
    float* mod = (float*)(p.ws + WS_MOD);
    LAS float* sc = lds;
    LAS float* red = lds + 1024 * 20;
    const int tid = opaque_tid();
    for (int e = tid; e < 17 * 1024; e += NTHREADS) { const int i = e >> 10, k = e & 1023; const float v = (i < 16) ? c[i * 1024 + k] : cctx[k]; sc[k * 20 + i] = siluf_(v); }
    __syncthreads();
    const int col = tid & 63, ks = tid >> 6;
    float acc[17];
#pragma unroll
    for (int i = 0; i < 17; ++i) acc[i] = 0.f;
    const float* wp = wm + (size_t)(ks * 128) * (NMOD * D) + ct * 64 + col;
#pragma unroll 16
    for (int k = 0; k < 128; ++k) {
        const float w = wp[(size_t)k * (NMOD * D)];
        const LAS f32x4* s4 = (const LAS f32x4*)(sc + (ks * 128 + k) * 20);
        const f32x4 a = s4[0], b = s4[1], cc = s4[2], d = s4[3]; const float e = sc[(ks * 128 + k) * 20 + 16];
        acc[0] += a[0] * w; acc[1] += a[1] * w; acc[2] += a[2] * w; acc[3] += a[3] * w;
        acc[4] += b[0] * w; acc[5] += b[1] * w; acc[6] += b[2] * w; acc[7] += b[3] * w;
        acc[8] += cc[0] * w; acc[9] += cc[1] * w; acc[10] += cc[2] * w; acc[11] += cc[3] * w;
        acc[12] += d[0] * w; acc[13] += d[1] * w; acc[14] += d[2] * w; acc[15] += d[3] * w;
        acc[16] += e * w;
    }
#pragma unroll
    for (int i = 0; i < 17; ++i) red[(ks * 17 + i) * 64 + col] = acc[i];
    __syncthreads();
    for (int e = tid; e < 17 * 64; e += NTHREADS) {
        const int i = e >> 6, cl = e & 63; float s = 0.f;
#pragma unroll
        for (int q = 0; q < 8; ++q) s += red[(q * 17 + i) * 64 + cl];
        mod[i * (NMOD * D) + ct * 64 + cl] = s + bm[ct * 64 + cl];
    }
    __syncthreads();
}

__device__ __forceinline__ void p0_prep(const Params& p, LAS unsigned char* lds) {
    LAS float* fl = (LAS float*)lds;
    const int tid = opaque_tid();
    for (int t = (int)blockIdx.x; t < 144; t += (int)gridDim.x) mod_task(p, t, fl);
    if (blockIdx.x == gridDim.x - 1) {
        float* lb = (float*)(p.ws + WS_LB); const float* hlb = p.in[14];
        for (int e = tid; e < 1024; e += NTHREADS) { const int dir = e >> 9, ch = e & 511; const float a0 = hlb[dir * 1024 + ch], a1 = hlb[dir * 1024 + 512 + ch]; lb[e] = 1.0f / (1.0f + __expf(a1 - a0)); }
        if (tid == 0) {
            float mq = 0.f, mk = 0.f;
            for (int i = 0; i < 64; ++i) { mq = fmaxf(mq, fabsf(p.in[12][i])); mk = fmaxf(mk, fabsf(p.in[13][i])); }
            ((float*)(p.ws + WS_ROPE))[2048] = 64.0f * mq * mk * (0.125f * 1.4426950408889634f) * 1.02f;
        }
        float* rope = (float*)(p.ws + WS_ROPE);
        for (int e = tid; e < 1024; e += NTHREADS) { const int pos = e >> 4, pp = e & 15; const float inv = exp2f(-(float)pp * (13.287712379549449f / 16.0f)); const float ang = (float)pos * inv;
            rope[e * 2] = __cosf(ang); rope[e * 2 + 1] = __sinf(ang); }

    }
    transpose_jobs(p, 0, 7, fl);
}

#define NP_LOAD(R, HH, YY, XX) do { const int r_ = (R); \
    if (hb) { _Pragma("unroll") for (int i = 0; i < 4; ++i) XX[i] = *(const u32x2*)(hb + (size_t)r_ * D + 256 * i + 4 * lane); } \
    else { const float* hrow_ = (r_ < TL) ? hx + (size_t)r_ * D : hc + (size_t)(r_ - TL) * D; \
        _Pragma("unroll") for (int i = 0; i < 4; ++i) HH[i] = *(const f32x4*)(hrow_ + 256 * i + 4 * lane); } \
    if (Y) { _Pragma("unroll") for (int i = 0; i < 4; ++i) YY[i] = *(const u32x2*)(Y + (size_t)r_ * D + 256 * i + 4 * lane); } } while (0)
#define NP_BODY(R, HH, YY, XX) do { const int r_ = (R); \
    const int bi_ = (r_ < TL) ? (r_ >> 11) : 16; \
    if (hb) { _Pragma("unroll") for (int i = 0; i < 4; ++i) HH[i] = (f32x4){bflo(XX[i].x), bfhi(XX[i].x), bflo(XX[i].y), bfhi(XX[i].y)}; } \
    if (bi_ != curb) { curb = bi_; const float* mrow = mod + bi_ * (NMOD * D); \
        _Pragma("unroll") for (int i = 0; i < 4; ++i) { if (Y) gt[i] = *(const f32x4*)(mrow + gate_idx * D + 256 * i + 4 * lane); \
            if (U) { sh[i] = *(const f32x4*)(mrow + shift_idx * D + 256 * i + 4 * lane); sc[i] = *(const f32x4*)(mrow + scale_idx * D + 256 * i + 4 * lane) + 1.0f; } } } \
    if (Y) { f32x4 y[4]; float ss = 0.f; \
        _Pragma("unroll") for (int i = 0; i < 4; ++i) { y[i] = (f32x4){bflo(YY[i].x), bfhi(YY[i].x), bflo(YY[i].y), bfhi(YY[i].y)}; \
            ss += y[i][0] * y[i][0] + y[i][1] * y[i][1] + y[i][2] * y[i][2] + y[i][3] * y[i][3]; } \
        ss = wave_sum(ss); const float rstd = rsqrtf(ss * (1.0f / D) + EPS) * coef; \
        _Pragma("unroll") for (int i = 0; i < 4; ++i) HH[i] += gt[i] * (y[i] * rstd * gpo[i]); } \
    if (hob && r_ < TL) { _Pragma("unroll") for (int i = 0; i < 4; ++i) { u32x2 w; w.x = pk2(HH[i][0], HH[i][1]); w.y = pk2(HH[i][2], HH[i][3]); \
        *(u32x2*)(hob + (size_t)r_ * D + 256 * i + 4 * lane) = w; \
        HH[i] = (f32x4){bflo(w.x), bfhi(w.x), bflo(w.y), bfhi(w.y)}; } }     \
    if (hout && r_ < TL) { _Pragma("unroll") for (int i = 0; i < 4; ++i) *(f32x4*)(hout + (size_t)r_ * D + 256 * i + 4 * lane) = HH[i]; } \
    if (U) { float ss = 0.f; \
        _Pragma("unroll") for (int i = 0; i < 4; ++i) ss += HH[i][0] * HH[i][0] + HH[i][1] * HH[i][1] + HH[i][2] * HH[i][2] + HH[i][3] * HH[i][3]; \
        ss = wave_sum(ss); const float rstd = rsqrtf(ss * (1.0f / D) + EPS); \
        _Pragma("unroll") for (int i = 0; i < 4; ++i) { const f32x4 u = (HH[i] * rstd * gpr[i]) * sc[i] + sh[i]; \
            u32x2 w; w.x = pk2(u[0], u[1]); w.y = pk2(u[2], u[3]); *(u32x2*)(U + (size_t)r_ * D + 256 * i + 4 * lane) = w; } } } while (0)
__device__ __forceinline__ void norm_pass(const bf16_t* __restrict__ Y, const float* hx, const float* hc, const bf16_t* hb, const float* __restrict__ mod,
                                          const float* __restrict__ gpost, int gate_idx, float coef, float* hout, bf16_t* hob,
                                          const float* __restrict__ gpre, int shift_idx, int scale_idx, bf16_t* __restrict__ U, int nrows) {
    const int tid_ = opaque_tid(); const int lane = tid_ & 63, wave = tid_ >> 6;
    const int W = (int)gridDim.x * 8, gw = (int)blockIdx.x * 8 + wave;
    const int rpw = (((nrows + W - 1) / W) + 1) & ~1;
    const int r0 = gw * rpw, r1 = (r0 + rpw < nrows) ? r0 + rpw : nrows;
    if (r0 < r1) {
        f32x4 gpo[4], gpr[4], gt[4], sh[4], sc[4];
#pragma unroll
        for (int i = 0; i < 4; ++i) { gpo[i] = Y ? *(const f32x4*)(gpost + 256 * i + 4 * lane) : (f32x4){0.f, 0.f, 0.f, 0.f}; gpr[i] = U ? *(const f32x4*)(gpre + 256 * i + 4 * lane) : (f32x4){0.f, 0.f, 0.f, 0.f};
            gt[i] = sh[i] = sc[i] = (f32x4){0.f, 0.f, 0.f, 0.f}; }
        int curb = -1;
        f32x4 hA[4], hB[4]; u32x2 yA[4], yB[4], xA[4], xB[4];
#pragma unroll
        for (int i = 0; i < 4; ++i) { yA[i] = yB[i] = xA[i] = xB[i] = (u32x2){0u, 0u}; hA[i] = hB[i] = (f32x4){0.f, 0.f, 0.f, 0.f}; }
        NP_LOAD(r0, hA, yA, xA);
        if (r0 + 1 < r1) NP_LOAD(r0 + 1, hB, yB, xB);
        for (int r = r0; r < r1; r += 2) {
            f32x4 hAn[4], hBn[4]; u32x2 yAn[4], yBn[4], xAn[4], xBn[4];
#pragma unroll
            for (int i = 0; i < 4; ++i) { hAn[i] = hBn[i] = (f32x4){0.f, 0.f, 0.f, 0.f}; yAn[i] = yBn[i] = xAn[i] = xBn[i] = (u32x2){0u, 0u}; }
            if (r + 2 < r1) NP_LOAD(r + 2, hAn, yAn, xAn);
            if (r + 3 < r1) NP_LOAD(r + 3, hBn, yBn, xBn);
            NP_BODY(r, hA, yA, xA);
            if (r + 1 < r1) NP_BODY(r + 1, hB, yB, xB);
#pragma unroll
            for (int i = 0; i < 4; ++i) { hA[i] = hAn[i]; yA[i] = yAn[i]; xA[i] = xAn[i]; hB[i] = hBn[i]; yB[i] = yBn[i]; xB[i] = xBn[i]; }
        }
    }
}

struct InOrder {
    pg8::StaticOrder so;
    __device__ void init(int G, int c) { so.init(TL, DIN, G, c); }
    __device__ bool next(int i, Unit& u) const {
        const long L = (long)i * so.G + so.c;
        if (L < so.nwg) return so.next(i, u);
        const int e = (int)(L - so.nwg); if (e >= 112) return false;
        const int pi = e >> 4; u.pm = 128 + (e & 15); u.pn = (pi == 0) ? 2 : (4 + pi); return true;
    }
    __device__ __forceinline__ void a_ready(const Unit&) const {}
    __device__ __forceinline__ void done(const Unit&) const {}
};

struct EpiSwiGLU {
    static constexpr bool PERM = true, AFTER_DRAIN = false, HAS_MID = false;
    bf16_t* H;
    __device__ __forceinline__ void operator()(const f32x4 (&acc)[2][2][4][2], const Unit& u, int wr, int wc, int fr, int fq) const {
        const int row0 = u.pm * 256 + wr * 64 + fr, col0 = u.pn * 128 + wc * 32 + 8 * fq;
#pragma unroll
        for (int ai = 0; ai < 2; ++ai)
#pragma unroll
            for (int m = 0; m < 4; ++m) {
                float v[8];
#pragma unroll
                for (int n = 0; n < 2; ++n)
#pragma unroll
                    for (int j = 0; j < 4; ++j) v[n * 4 + j] = siluf_(acc[ai][0][m][n][j]) * acc[ai][1][m][n][j];
                u32x4 w; w.x = pk2(v[0], v[1]); w.y = pk2(v[2], v[3]); w.z = pk2(v[4], v[5]); w.w = pk2(v[6], v[7]);
                *(u32x4*)(H + (size_t)(row0 + ai * 128 + m * 16) * DFF + col0) = w;
            }
    }
};
struct EpiStore {
    static constexpr bool PERM = true, AFTER_DRAIN = false, HAS_MID = false;
    bf16_t* O; int ldc;
    __device__ __forceinline__ void operator()(const f32x4 (&acc)[2][2][4][2], const Unit& u, int wr, int wc, int fr, int fq) const {
        const int row0 = u.pm * 256 + wr * 64 + fr, col0 = u.pn * 256 + wc * 32 + 8 * fq;
#pragma unroll
        for (int ai = 0; ai < 2; ++ai)
#pragma unroll
            for (int m = 0; m < 4; ++m)
#pragma unroll
                for (int bj = 0; bj < 2; ++bj) {
                    const f32x4 a = acc[ai][bj][m][0], b = acc[ai][bj][m][1];
                    u32x4 w; w.x = pk2(a[0], a[1]); w.y = pk2(a[2], a[3]); w.z = pk2(b[0], b[1]); w.w = pk2(b[2], b[3]);
                    *(u32x4*)(O + (size_t)(row0 + ai * 128 + m * 16) * ldc + col0 + bj * 128) = w;
                }
    }
};
struct EpiMerge2 {
    static constexpr bool PERM = true, AFTER_DRAIN = false, HAS_MID = true;
    bf16_t* Yo; const bf16_t* P;
    __device__ __forceinline__ void mid(f32x4 (&acc)[2][2][4][2], const Unit& u, int wr, int wc, int fr, int fq) const {
        asm volatile("" : "+v"(fr), "+v"(fq));
        const int row0 = u.pm * 256 + wr * 64 + fr, col0 = u.pn * 256 + wc * 32 + 8 * fq;
#pragma unroll
        for (int ai = 0; ai < 2; ++ai)
#pragma unroll
            for (int m = 0; m < 4; ++m)
#pragma unroll
                for (int bj = 0; bj < 2; ++bj) {
                    const size_t r = (size_t)(row0 + ai * 128 + m * 16); const int c = col0 + bj * 128;
                    const u32x4 ga = *(const u32x4*)(P + r * PW + 2560 + c), gb = *(const u32x4*)(P + r * PW + 3584 + c);
                    const float q0 = bflo(ga.x) * __builtin_amdgcn_rcpf(bflo(gb.x)), q1 = bfhi(ga.x) * __builtin_amdgcn_rcpf(bfhi(gb.x));
                    const float q2 = bflo(ga.y) * __builtin_amdgcn_rcpf(bflo(gb.y)), q3 = bfhi(ga.y) * __builtin_amdgcn_rcpf(bfhi(gb.y));
                    const float q4 = bflo(ga.z) * __builtin_amdgcn_rcpf(bflo(gb.z)), q5 = bfhi(ga.z) * __builtin_amdgcn_rcpf(bfhi(gb.z));
                    const float q6 = bflo(ga.w) * __builtin_amdgcn_rcpf(bflo(gb.w)), q7 = bfhi(ga.w) * __builtin_amdgcn_rcpf(bfhi(gb.w));
                    acc[ai][bj][m][0] *= (f32x4){q0, q1, q2, q3}; acc[ai][bj][m][1] *= (f32x4){q4, q5, q6, q7};
                    asm volatile("" ::: "memory");
                }
    }
    __device__ __forceinline__ void operator()(const f32x4 (&acc)[2][2][4][2], const Unit& u, int wr, int wc, int fr, int fq) const {
        const int row0 = u.pm * 256 + wr * 64 + fr, col0 = u.pn * 256 + wc * 32 + 8 * fq;
#pragma unroll
        for (int ai = 0; ai < 2; ++ai)
#pragma unroll
            for (int m = 0; m < 4; ++m)
#pragma unroll
                for (int bj = 0; bj < 2; ++bj) {
                    const size_t r = (size_t)(row0 + ai * 128 + m * 16); const int c = col0 + bj * 128;
                    const u32x4 g = *(const u32x4*)(P + r * PW + 3584 + c);
                    const f32x4 a = acc[ai][bj][m][0], b = acc[ai][bj][m][1];
                    u32x4 w; w.x = pk2(a[0] * bflo(g.x), a[1] * bfhi(g.x)); w.y = pk2(a[2] * bflo(g.y), a[3] * bfhi(g.y)); w.z = pk2(b[0] * bflo(g.z), b[1] * bfhi(g.z)); w.w = pk2(b[2] * bflo(g.w), b[3] * bfhi(g.w));
                    *(u32x4*)(Yo + r * D + c) = w;
                }
    }
};
struct EpiIn {
    static constexpr bool PERM = true, AFTER_DRAIN = false, HAS_MID = false;
    bf16_t* P; bf16_t* Pc; bf16_t* Qn; bf16_t* Kn; bf16_t* Vt; const float* qg; const float* kg; const float* lb; const float* rope;
    __device__ __forceinline__ void operator()(const f32x4 (&acc)[2][2][4][2], const Unit& u, int wr, int wc, int fr, int fq) const {
        const int pn = u.pn; const bool isctx = u.pm >= 128;
        const int row0 = u.pm * 256 + wr * 64 + fr;
        if (pn <= 2) {
            if (pn == 2 && wc >= 2) {
                const int kvh = wc - 2;
#pragma unroll
                for (int ai = 0; ai < 2; ++ai)
#pragma unroll
                    for (int m = 0; m < 4; ++m) {
                        const int row = row0 + ai * 128 + m * 16;
                        int b, key; if (!isctx) { b = row >> 11; key = row & 2047; } else { const int rc = row - TL; b = rc >> 8; key = SEQ + (rc & 255); }
                        bf16_t* base = Vt + (size_t)((b * 2 + kvh) * 64) * NKEY + key;
#pragma unroll
                        for (int bj = 0; bj < 2; ++bj)
#pragma unroll
                            for (int n = 0; n < 2; ++n)
#pragma unroll
                                for (int j = 0; j < 4; j += 2) {
                                    const unsigned w = pk2(acc[ai][bj][m][n][j], acc[ai][bj][m][n][j + 1]);
                                    const int d = 32 * bj + 8 * fq + 4 * n + j;
                                    base[(size_t)d * NKEY] = (bf16_t)(w & 0xffffu); base[(size_t)(d + 1) * NKEY] = (bf16_t)(w >> 16);
                                }
                    }
            } else {
                const bool isk = (pn == 2);
                const float* gain = isk ? kg : qg;
                float gn[2][8];
#pragma unroll
                for (int bj = 0; bj < 2; ++bj)
#pragma unroll
                    for (int e = 0; e < 8; ++e) gn[bj][e] = gain[32 * bj + 8 * fq + e];
                const float osc = isk ? 1.0f : (0.125f * 1.4426950408889634f);
#pragma unroll
                for (int ai = 0; ai < 2; ++ai)
#pragma unroll
                    for (int m = 0; m < 4; ++m) {
                        const int row = row0 + ai * 128 + m * 16;
                        float y[2][8]; float ss = 0.f;
#pragma unroll
                        for (int bj = 0; bj < 2; ++bj)
#pragma unroll
                            for (int n = 0; n < 2; ++n)
#pragma unroll
                                for (int j = 0; j < 4; ++j) { const float v = acc[ai][bj][m][n][j]; y[bj][n * 4 + j] = v; ss += v * v; }
                        ss += __shfl_xor(ss, 16); ss += __shfl_xor(ss, 32);
                        const float rstd = rsqrtf(ss * (1.0f / 64.0f) + EPS);
#pragma unroll
                        for (int bj = 0; bj < 2; ++bj)
#pragma unroll
                            for (int e = 0; e < 8; ++e) y[bj][e] *= rstd * gn[bj][e];
                        if (!isctx) {
                            const int t = row & 2047;
#pragma unroll
                            for (int bj = 0; bj < 2; ++bj) {
                                const int pos = bj ? (t & 63) : (t >> 6);
                                const float* rp = rope + (pos * 16 + 8 * (fq & 1)) * 2;
#pragma unroll
                                for (int e = 0; e < 8; e += 2) {
                                    const f32x4 cs = *(const f32x4*)(rp + e * 2);
                                    const float p0 = __shfl_xor(y[bj][e], 32), p1 = __shfl_xor(y[bj][e + 1], 32);
                                    const float s0 = (fq >> 1) ? p0 : -p0, s1 = (fq >> 1) ? p1 : -p1;
                                    y[bj][e] = y[bj][e] * cs[0] + s0 * cs[1]; y[bj][e + 1] = y[bj][e + 1] * cs[2] + s1 * cs[3];
                                }
                            }
                        }
                        bf16_t* dst;
                        if (!isk) dst = Qn + (size_t)row * 512 + (4 * pn + wc) * 64 + 8 * fq;
                        else { int b, key; if (!isctx) { b = row >> 11; key = row & 2047; } else { const int rc = row - TL; b = rc >> 8; key = SEQ + (rc & 255); }
                               dst = Kn + ((size_t)(b * 2 + wc) * NKEY + key) * 64 + 8 * fq; }
#pragma unroll
                        for (int bj = 0; bj < 2; ++bj) {
                            u32x4 w; w.x = pk2(y[bj][0] * osc, y[bj][1] * osc); w.y = pk2(y[bj][2] * osc, y[bj][3] * osc); w.z = pk2(y[bj][4] * osc, y[bj][5] * osc); w.w = pk2(y[bj][6] * osc, y[bj][7] * osc);
                            *(u32x4*)(dst + 32 * bj) = w;
                        }
                    }
            }
        } else {
            const int cls = (pn <= 4) ? 0 : (pn <= 6) ? 1 : (pn <= 8) ? 2 : (pn <= 10) ? 3 : (pn <= 12) ? 4 : 5;
#pragma unroll
            for (int bj = 0; bj < 2; ++bj) {
                const int c = pn * 256 + bj * 128 + wc * 32 + 8 * fq;
                float lbv[8];
                if (cls == 2 || cls == 3) {
                    const float* lp = lb + (cls == 3 ? 512 : 0) + (c - (cls == 3 ? 2304 : 1792));
#pragma unroll
                    for (int e = 0; e < 8; ++e) lbv[e] = 1.0f - lp[e];
                }
#pragma unroll
                for (int ai = 0; ai < 2; ++ai)
#pragma unroll
                    for (int m = 0; m < 4; ++m) {
                        const int row = row0 + ai * 128 + m * 16;
                        float v[8];
#pragma unroll
                        for (int n = 0; n < 2; ++n)
#pragma unroll
                            for (int j = 0; j < 4; ++j) v[n * 4 + j] = acc[ai][bj][m][n][j];
                        u32x4 w;
                        if (cls == 0) {
#pragma unroll
                            for (int e = 0; e < 8; ++e) v[e] = siluf_(v[e]) * 0.08838834764831845f; }
                        else if (cls == 4) {
#pragma unroll
                            for (int e = 0; e < 8; ++e) v[e] = siluf_(v[e]); }
                        else if (cls == 5) {
#pragma unroll
                            for (int e = 0; e < 8; ++e) v[e] = sigmoidf_(v[e]); }
                        if (cls == 2 || cls == 3) {
#pragma unroll
                            for (int e = 0; e < 8; ++e) v[e] = lbv[e] * sigmoidf_(-v[e]);
                            w.x = pkh2(v[0], v[1]); w.y = pkh2(v[2], v[3]); w.z = pkh2(v[4], v[5]); w.w = pkh2(v[6], v[7]);
                        } else { w.x = pk2(v[0], v[1]); w.y = pk2(v[2], v[3]); w.z = pk2(v[4], v[5]); w.w = pk2(v[6], v[7]); }
                        if (!isctx) *(u32x4*)(P + (size_t)row * PW + (c - 768)) = w;
                        else *(u32x4*)(Pc + (size_t)(row - TL) * PCW + (c - 1280)) = w;
                    }
            }
        }
    }
};

constexpr int AK_PITCH = 144, AV_PITCH = 136, AK_BYTES = 64 * AK_PITCH, AV_BYTES = 64 * AV_PITCH;
constexpr int ATILE_BYTES = AK_BYTES + AV_BYTES;
#define ATT_TILE(TT_, SC_, SN_) do { \
        const bool own_ = ((TT_) + 2 < NT); const int tl = own_ ? (TT_) + 2 : (TT_) + 2 - NT; \
        const bf16_t* Ks_ = own_ ? Kb : Kbn; const bf16_t* Vs_ = own_ ? Vb : Vbn; \
        const u32x4 kreg = *(const u32x4*)(Ks_ + (size_t)(tl * 64 + srow) * 64 + sch * 8); \
        const u32x4 vreg = *(const u32x4*)(Vs_ + (size_t)srow * NKEY + tl * 64 + sch * 8); \
_Pragma("unroll") \
        for (int kb = 0; kb < 2; ++kb) { \
_Pragma("unroll") \
            for (int i = 0; i < 16; ++i) SN_[kb][i] = 0.f; \
_Pragma("unroll") \
            for (int ks = 0; ks < 4; ++ks) { const bf16x8 a = *(const LAS bf16x8*)(lds + bufn + kroff + 32 * kb * AK_PITCH + 32 * ks); \
                SN_[kb] = __builtin_amdgcn_mfma_f32_32x32x16_bf16(a, qf[ks], SN_[kb], 0, 0, 0); } \
        } \
        f32x2_t m2 = {0.f, 0.f}; \
        if (!BOUNDED) { \
            float mx = SC_[0][0]; \
_Pragma("unroll") \
            for (int i = 1; i < 16; ++i) mx = fmaxf(mx, SC_[0][i]); \
_Pragma("unroll") \
            for (int i = 0; i < 16; ++i) mx = fmaxf(mx, SC_[1][i]); \
            mx = fmaxf(mx, __shfl_xor(mx, 32)); \
            const float mnew = fmaxf(mrun, mx); \
            if (__any(mnew > mrun)) { \
                const float alpha = __builtin_amdgcn_exp2f(mrun - mnew); \
                lrun *= alpha; \
_Pragma("unroll") \
                for (int i = 0; i < 16; ++i) { o[0][i] *= alpha; o[1][i] *= alpha; } \
            } \
            mrun = mnew; \
            m2 = (f32x2_t){mnew, mnew}; \
        } \
        float psx = 0.f, psy = 0.f; \
        u32x4 pw[2][2]; \
_Pragma("unroll") \
        for (int kb = 0; kb < 2; ++kb) \
_Pragma("unroll") \
            for (int ks = 0; ks < 2; ++ks) { \
                unsigned w4[4]; \
_Pragma("unroll") \
                for (int j2 = 0; j2 < 4; ++j2) { \
                    f32x2_t v = (f32x2_t){SC_[kb][8 * ks + 2 * j2], SC_[kb][8 * ks + 2 * j2 + 1]}; \
                    if (!BOUNDED) v -= m2; \
                    v.x = __builtin_amdgcn_exp2f(v.x); v.y = __builtin_amdgcn_exp2f(v.y); \
                    psx += v.x; psy += v.y; w4[j2] = pk2(v.x, v.y); \
                } \
                pw[kb][ks] = (u32x4){w4[0], w4[1], w4[2], w4[3]}; \
            } \
        lrun += psx + psy; \
_Pragma("unroll") \
        for (int kb = 0; kb < 2; ++kb) \
_Pragma("unroll") \
            for (int ks = 0; ks < 2; ++ks) { \
                const bf16x8 pf = __builtin_bit_cast(bf16x8, pw[kb][ks]); \
_Pragma("unroll") \
                for (int db = 0; db < 2; ++db) { \
                    LAS unsigned char* vp = lds + bufc + vroff + 32 * db * AV_PITCH + (32 * kb + 16 * ks) * 2; \
                    const u32x2 lo = *(const LAS u32x2*)vp, hi = *(const LAS u32x2*)(vp + 16); \
                    const bf16x8 a = __builtin_bit_cast(bf16x8, (u32x4){lo.x, lo.y, hi.x, hi.y}); \
                    o[db] = __builtin_amdgcn_mfma_f32_32x32x16_bf16(a, pf, o[db], 0, 0, 0); \
                } \
            } \
        *(LAS u32x4*)(lds + bufw + kwoff) = kreg; \
        { LAS u32x2* vp = (LAS u32x2*)(lds + bufw + vwoff); vp[0] = (u32x2){vreg.x, vreg.y}; vp[1] = (u32x2){vreg.z, vreg.w}; } \
        __syncthreads(); \
        { const int tmp = bufc; bufc = bufn; bufn = bufw; bufw = tmp; } \
    } while (0)
template <bool BOUNDED>
__device__ __forceinline__ void attn_phase(unsigned* ctl, const bf16_t* __restrict__ Kn, const bf16_t* __restrict__ Vt, const bf16_t* __restrict__ QO, bf16_t* __restrict__ OM, LAS unsigned char* lds) {
    volatile LAS unsigned* bc = (volatile LAS unsigned*)(lds + MISC_OFF);
    const int tid = opaque_tid(), wave = tid >> 6, lane = tid & 63, r32 = lane & 31, hh = lane >> 5;
    const int srow = tid >> 3, sch = tid & 7;
    const int kwoff = srow * AK_PITCH + sch * 16, vwoff = AK_BYTES + srow * AV_PITCH + sch * 16;
    const int kroff = r32 * AK_PITCH + 16 * hh, vroff = AK_BYTES + r32 * AV_PITCH + 8 * hh;
    constexpr int NT = NKEY / 64;
    __syncthreads();
    if (tid == 0) bc[0] = atomicAdd(ctl, 1u);
    __syncthreads();
    unsigned cur = bc[0];
    if (cur >= 1024u) return;
    bf16x8 qf[4];
    {
        const int g = cur & 3, qb = (cur >> 2) & 7, bk = cur >> 5, b = bk >> 1, kvh = bk & 1, h = kvh * 4 + g;
        const size_t tok = (size_t)b * SEQ + qb * 256 + wave * 32 + r32;
#pragma unroll
        for (int s = 0; s < 4; ++s) qf[s] = *(const bf16x8*)(QO + tok * 512 + h * 64 + 16 * s + 8 * hh);
        const bf16_t* Kb = Kn + (size_t)bk * NKEY * 64; const bf16_t* Vb = Vt + (size_t)bk * 64 * NKEY;
#pragma unroll
        for (int sb = 0; sb < 2; ++sb) {
            const u32x4 kr = *(const u32x4*)(Kb + (size_t)(sb * 64 + srow) * 64 + sch * 8);
            const u32x4 vr = *(const u32x4*)(Vb + (size_t)srow * NKEY + sb * 64 + sch * 8);
            *(LAS u32x4*)(lds + sb * ATILE_BYTES + kwoff) = kr;
            LAS u32x2* vp = (LAS u32x2*)(lds + sb * ATILE_BYTES + vwoff); vp[0] = (u32x2){vr.x, vr.y}; vp[1] = (u32x2){vr.z, vr.w};
        }
    }
    __syncthreads();
    int bufc = 0, bufn = ATILE_BYTES, bufw = 2 * ATILE_BYTES;
    int par = 1;
    for (;;) {
        const int g = cur & 3, qb = (cur >> 2) & 7, bk = cur >> 5, b = bk >> 1, kvh = bk & 1, h = kvh * 4 + g;
        const size_t tok = (size_t)b * SEQ + qb * 256 + wave * 32 + r32;
        const bf16_t* Kb = Kn + (size_t)bk * NKEY * 64; const bf16_t* Vb = Vt + (size_t)bk * 64 * NKEY;
        const bf16_t* Kbn = Kb; const bf16_t* Vbn = Vb;
        unsigned nxt = 0xffffffffu;
        bf16x8 qn[4];
#pragma unroll
        for (int s = 0; s < 4; ++s) qn[s] = qf[s];
        f32x16 o[2];
#pragma unroll
        for (int i = 0; i < 16; ++i) { o[0][i] = 0.f; o[1][i] = 0.f; }
        float mrun = -1e30f, lrun = 0.f;
        f32x16 sc[2];
#pragma unroll
        for (int kb = 0; kb < 2; ++kb) {
#pragma unroll
            for (int i = 0; i < 16; ++i) sc[kb][i] = 0.f;
#pragma unroll
            for (int ks = 0; ks < 4; ++ks) { const bf16x8 a = *(const LAS bf16x8*)(lds + bufc + kroff + 32 * kb * AK_PITCH + 32 * ks);
                sc[kb] = __builtin_amdgcn_mfma_f32_32x32x16_bf16(a, qf[ks], sc[kb], 0, 0, 0); }
        }
        f32x16 sd[2];
        for (int t = 0; t < NT; t += 2) {
            if (t == NT - 8) { if (tid == 0) bc[par] = atomicAdd(ctl, 1u); }
            if (t == NT - 4) {
                nxt = bc[par];
                if (nxt < 1024u) {
                    const int gn = nxt & 3, qbn = (nxt >> 2) & 7, bkn = nxt >> 5, bn = bkn >> 1, hn = (bkn & 1) * 4 + gn;
                    Kbn = Kn + (size_t)bkn * NKEY * 64; Vbn = Vt + (size_t)bkn * 64 * NKEY;
                    const size_t tokn = (size_t)bn * SEQ + qbn * 256 + wave * 32 + r32;
#pragma unroll
                    for (int s = 0; s < 4; ++s) qn[s] = *(const bf16x8*)(QO + tokn * 512 + hn * 64 + 16 * s + 8 * hh);
                }
            }
            ATT_TILE(t, sc, sd);
            ATT_TILE(t + 1, sd, sc);
        }
        const float l = lrun + __shfl_xor(lrun, 32); const float inv = 1.0f / l;
#pragma unroll
        for (int db = 0; db < 2; ++db)
#pragma unroll
            for (int g4 = 0; g4 < 4; ++g4) {
                u32x2 w; w.x = pk2(o[db][4 * g4] * inv, o[db][4 * g4 + 1] * inv); w.y = pk2(o[db][4 * g4 + 2] * inv, o[db][4 * g4 + 3] * inv);
                *(u32x2*)(OM + tok * 1024 + h * 64 + 32 * db + 8 * g4 + 4 * hh) = w;
            }
        if (nxt >= 1024u) break;
        cur = nxt; par ^= 1;
#pragma unroll
        for (int s = 0; s < 4; ++s) qf[s] = qn[s];
    }
}

constexpr int HQ1 = 0, HK1 = 17408, HQH = 34816, HKT = 52224, HVT = 68608, HAI = 84992, HTOT = 94208, HEL = 102400;
constexpr int HP = 272;
__device__ __forceinline__ int swz128(int row, int s) { return row * 128 + (((((s >> 3) ^ (row >> 3) ^ (row >> 1)) & 7)) << 4) + (s & 7) * 2; }
__device__ __forceinline__ void hgrn_item(int item, const bf16_t* __restrict__ P, const bf16_t* __restrict__ Pc, bf16_t* __restrict__ OHF, bf16_t* __restrict__ OHB, LAS unsigned char* lds) {
    const int dir = item & 1, head = (item >> 1) & 3, b = item >> 3;
    const int tid = opaque_tid(), w = tid >> 6, lane = tid & 63, l15 = lane & 15, q4 = lane >> 4;
    const int cgi = tid & 31, sg = tid >> 5;
    const int sp = tid >> 4, vg = tid & 15;
    bf16_t* Oout = dir ? OHB : OHF;
    f32x4 S[8];
#pragma unroll
    for (int i = 0; i < 8; ++i) S[i] = (f32x4){0.f, 0.f, 0.f, 0.f};
#define HG_LOAD(NC) do { const int n_ = (NC); const bool ic_ = n_ < 4; const int nn_ = ic_ ? n_ : n_ - 4; \
        _Pragma("unroll") for (int st = 0; st < 4; ++st) { const int pos = 64 * nn_ + 4 * sg + st; \
            if (ic_) { const int tk = dir ? (CTXL - 1 - pos) : pos; const bf16_t* rp = Pc + (size_t)(b * CTXL + tk) * PCW; \
                kraw[st] = *(const u32x2*)(rp + 512 + dir * 512 + head * 128 + 4 * cgi); qraw[st] = (u32x2){0u, 0u}; } \
            else { const int tk = dir ? (SEQ - 1 - pos) : pos; const bf16_t* rp = P + (size_t)(b * SEQ + tk) * PW; \
                kraw[st] = *(const u32x2*)(rp + 1024 + dir * 512 + head * 128 + 4 * cgi); qraw[st] = *(const u32x2*)(rp + head * 128 + 4 * cgi); } } \
        _Pragma("unroll") for (int e = 0; e < 2; ++e) { const int pos = 64 * nn_ + 2 * sp + e; \
            if (ic_) { const int tk = dir ? (CTXL - 1 - pos) : pos; vraw[e] = *(const u32x4*)(Pc + (size_t)(b * CTXL + tk) * PCW + head * 128 + 8 * vg); } \
            else { const int tk = dir ? (SEQ - 1 - pos) : pos; vraw[e] = *(const u32x4*)(P + (size_t)(b * SEQ + tk) * PW + 512 + head * 128 + 8 * vg); } } } while (0)
    u32x2 kraw[4], qraw[4]; u32x4 vraw[2];
    HG_LOAD(0);
    for (int n = 0; n < 36; ++n) {
        const bool isctx = n < 4; const int nn = isctx ? n : n - 4;
        f32x4 kv[4], El[4];
#pragma unroll
        for (int st = 0; st < 4; ++st) {
            kv[st] = (f32x4){hlo(kraw[st].x), hhi(kraw[st].x), hlo(kraw[st].y), hhi(kraw[st].y)};
            const f32x4 f = 1.0f - kv[st];
            El[st] = (st == 0) ? f : El[st - 1] * f;
        }
        *(LAS f32x4*)(lds + HTOT + (sg * 128 + 4 * cgi) * 4) = El[3];
        __syncthreads();
        f32x4 pre = (f32x4){1.f, 1.f, 1.f, 1.f}, mypre = pre, emid = pre;
#pragma unroll
        for (int s2 = 0; s2 < 16; ++s2) {
            const f32x4 tv = *(const LAS f32x4*)(lds + HTOT + (s2 * 128 + 4 * cgi) * 4);
            if (s2 == sg) mypre = pre;
            pre *= tv;
            if (s2 == 7) emid = pre;
        }
        const f32x4 elast = pre;
        f32x4 remid; remid[0] = __frcp_rn(emid[0]); remid[1] = __frcp_rn(emid[1]); remid[2] = __frcp_rn(emid[2]); remid[3] = __frcp_rn(emid[3]);
        f32x4 kh[4], Rv[4];
        { const f32x4 E3 = mypre * El[3];
          Rv[3][0] = __builtin_amdgcn_rcpf(E3[0]); Rv[3][1] = __builtin_amdgcn_rcpf(E3[1]); Rv[3][2] = __builtin_amdgcn_rcpf(E3[2]); Rv[3][3] = __builtin_amdgcn_rcpf(E3[3]);
          Rv[2] = Rv[3] * (1.0f - kv[3]); Rv[1] = Rv[2] * (1.0f - kv[2]); Rv[0] = Rv[1] * (1.0f - kv[1]); }
#pragma unroll
        for (int st = 0; st < 4; ++st) {
            const f32x4 E = mypre * El[st];
            const f32x4 R = Rv[st];
            const f32x4 kr = kv[st] * R;
            kh[st] = kr * elast;
            if (!isctx) {
                const f32x4 qv = (f32x4){bflo(qraw[st].x), bfhi(qraw[st].x), bflo(qraw[st].y), bfhi(qraw[st].y)};
                const f32x4 qe = qv * E, q1 = qe * remid, k1 = kr * emid;
                const int off = (4 * sg + st) * HP + 8 * cgi;
                *(LAS u32x2*)(lds + HQH + off) = (u32x2){pk2(qe[0], qe[1]), pk2(qe[2], qe[3])};
                *(LAS u32x2*)(lds + HQ1 + off) = (u32x2){pk2(q1[0], q1[1]), pk2(q1[2], q1[3])};
                *(LAS u32x2*)(lds + HK1 + off) = (u32x2){pk2(k1[0], k1[1]), pk2(k1[2], k1[3])};
            }
        }
#pragma unroll
        for (int i = 0; i < 4; ++i) {
            const int ch = 4 * cgi + i;
            *(LAS u32x2*)(lds + HKT + swz128(ch, 4 * sg)) = (u32x2){pk2(kh[0][i], kh[1][i]), pk2(kh[2][i], kh[3][i])};
        }
        if (sg == 0) *(LAS f32x4*)(lds + HEL + 16 * cgi) = elast;
        {
            const unsigned a[4] = {vraw[0].x, vraw[0].y, vraw[0].z, vraw[0].w}, c2[4] = {vraw[1].x, vraw[1].y, vraw[1].z, vraw[1].w};
#pragma unroll
            for (int i = 0; i < 4; ++i) {
                const unsigned lo = (a[i] & 0xffffu) | (c2[i] << 16), hi = (a[i] >> 16) | (c2[i] & 0xffff0000u);
                *(LAS unsigned*)(lds + HVT + swz128(8 * vg + 2 * i, 2 * sp)) = lo;
                *(LAS unsigned*)(lds + HVT + swz128(8 * vg + 2 * i + 1, 2 * sp)) = hi;
            }
        }
        if (n + 1 < 36) HG_LOAD(n + 1);
        __syncthreads();
        f32x4 O[4];
#pragma unroll
        for (int i = 0; i < 4; ++i) O[i] = (f32x4){0.f, 0.f, 0.f, 0.f};
        if (!isctx) {
#pragma unroll
            for (int tt = 0; tt < 2; ++tt) {
                const int tl = 2 * w + tt, st_ = tl >> 2, ct = tl & 3;
                f32x4 c4 = (f32x4){0.f, 0.f, 0.f, 0.f};
                if (st_ <= ct) {
#pragma unroll
                    for (int ks = 0; ks < 4; ++ks) {
                        const bf16x8 a = *(const LAS bf16x8*)(lds + HK1 + (16 * st_ + l15) * HP + (32 * ks + 8 * q4) * 2);
                        const bf16x8 bb = *(const LAS bf16x8*)(lds + HQ1 + (16 * ct + l15) * HP + (32 * ks + 8 * q4) * 2);
                        c4 = __builtin_amdgcn_mfma_f32_16x16x32_bf16(a, bb, c4, 0, 0, 0);
                    }
                    const int cc = 16 * ct + l15, s0 = 16 * st_ + 4 * q4;
#pragma unroll
                    for (int j = 0; j < 4; ++j) if (s0 + j > cc) c4[j] = 0.f;
                }
                *(LAS u32x2*)(lds + HAI + (16 * ct + l15) * 144 + (16 * st_ + 4 * q4) * 2) = (u32x2){pk2(c4[0], c4[1]), pk2(c4[2], c4[3])};
            }
#pragma unroll
            for (int ks = 0; ks < 4; ++ks) {
                const f32x4 s0 = S[2 * ks], s1 = S[2 * ks + 1];
                const bf16x8 a = __builtin_bit_cast(bf16x8, (u32x4){pk2(s0[0], s0[1]), pk2(s0[2], s0[3]), pk2(s1[0], s1[1]), pk2(s1[2], s1[3])});
#pragma unroll
                for (int ct = 0; ct < 4; ++ct) {
                    LAS unsigned char* qp = lds + HQH + (16 * ct + l15) * HP + (32 * ks + 4 * q4) * 2;
                    const u32x2 lo = *(const LAS u32x2*)qp, hi = *(const LAS u32x2*)(qp + 32);
                    const bf16x8 bb = __builtin_bit_cast(bf16x8, (u32x4){lo.x, lo.y, hi.x, hi.y});
                    O[ct] = __builtin_amdgcn_mfma_f32_16x16x32_bf16(a, bb, O[ct], 0, 0, 0);
                }
            }
            __syncthreads();
#pragma unroll
            for (int ks = 0; ks < 2; ++ks) {
                const bf16x8 a = *(const LAS bf16x8*)(lds + HVT + swz128(16 * w + l15, 32 * ks + 8 * q4));
#pragma unroll
                for (int ct = 0; ct < 4; ++ct) {
                    const bf16x8 bb = *(const LAS bf16x8*)(lds + HAI + (16 * ct + l15) * 144 + (32 * ks + 8 * q4) * 2);
                    O[ct] = __builtin_amdgcn_mfma_f32_16x16x32_bf16(a, bb, O[ct], 0, 0, 0);
                }
            }
#pragma unroll
            for (int ct = 0; ct < 4; ++ct) {
                const int pos = 64 * nn + 16 * ct + l15; const int tk = dir ? (SEQ - 1 - pos) : pos;
                *(u32x2*)(Oout + (size_t)(b * SEQ + tk) * 512 + head * 128 + 16 * w + 4 * q4) = (u32x2){pk2(O[ct][0], O[ct][1]), pk2(O[ct][2], O[ct][3])};
            }
        }
        {
            bf16x8 vb2[2];
#pragma unroll
            for (int ks = 0; ks < 2; ++ks) vb2[ks] = *(const LAS bf16x8*)(lds + HVT + swz128(16 * w + l15, 32 * ks + 8 * q4));
#pragma unroll
            for (int cht = 0; cht < 8; ++cht) {
                const f32x4 el = *(const LAS f32x4*)(lds + HEL + (16 * cht + 4 * q4) * 4);
                S[cht] *= el;
#pragma unroll
                for (int ks = 0; ks < 2; ++ks) {
                    const bf16x8 a = *(const LAS bf16x8*)(lds + HKT + swz128(16 * cht + l15, 32 * ks + 8 * q4));
                    S[cht] = __builtin_amdgcn_mfma_f32_16x16x32_bf16(a, vb2[ks], S[cht], 0, 0, 0);
                }
            }
        }
    }
    __syncthreads();
}

__device__ __forceinline__ void hg_out_pass(const bf16_t* __restrict__ OHF, const bf16_t* __restrict__ OHB, const bf16_t* __restrict__ P, const float* __restrict__ hgain, bf16_t* __restrict__ OM) {
    const int tid_ = opaque_tid(); const int lane = tid_ & 63, wave = tid_ >> 6;
    float gn[8];
#pragma unroll
    for (int e = 0; e < 8; ++e) gn[e] = hgain[(lane & 15) * 8 + e];
    const int W = (int)gridDim.x * 8, gw = (int)blockIdx.x * 8 + wave;
    const int rpw = (TL + W - 1) / W;
    const int r0 = gw * rpw, r1 = (r0 + rpw < TL) ? r0 + rpw : TL;
    if (r0 < r1) {
        u32x4 a = *(const u32x4*)(OHF + (size_t)r0 * 512 + lane * 8), c = *(const u32x4*)(OHB + (size_t)r0 * 512 + lane * 8), gt = *(const u32x4*)(P + (size_t)r0 * PW + 2048 + lane * 8);
        for (int r = r0; r < r1; ++r) {
            u32x4 an = a, cn = c, gtn = gt;
            if (r + 1 < r1) { an = *(const u32x4*)(OHF + (size_t)(r + 1) * 512 + lane * 8); cn = *(const u32x4*)(OHB + (size_t)(r + 1) * 512 + lane * 8); gtn = *(const u32x4*)(P + (size_t)(r + 1) * PW + 2048 + lane * 8); }
            float v[8] = {bflo(a.x) + bflo(c.x), bfhi(a.x) + bfhi(c.x), bflo(a.y) + bflo(c.y), bfhi(a.y) + bfhi(c.y), bflo(a.z) + bflo(c.z), bfhi(a.z) + bfhi(c.z), bflo(a.w) + bflo(c.w), bfhi(a.w) + bfhi(c.w)};
            float ss = 0.f;
#pragma unroll
            for (int e = 0; e < 8; ++e) ss += v[e] * v[e];
            ss += __shfl_xor(ss, 1); ss += __shfl_xor(ss, 2); ss += __shfl_xor(ss, 4); ss += __shfl_xor(ss, 8);
            const float rstd = rsqrtf(ss * (1.0f / 128.0f) + EPS);
            const float gg[8] = {bflo(gt.x), bfhi(gt.x), bflo(gt.y), bfhi(gt.y), bflo(gt.z), bfhi(gt.z), bflo(gt.w), bfhi(gt.w)};
#pragma unroll
            for (int e = 0; e < 8; ++e) v[e] = v[e] * rstd * gn[e] * gg[e];
            u32x4 wv; wv.x = pk2(v[0], v[1]); wv.y = pk2(v[2], v[3]); wv.z = pk2(v[4], v[5]); wv.w = pk2(v[6], v[7]);
            *(u32x4*)(OM + (size_t)r * 1024 + 512 + lane * 8) = wv;
            a = an; c = cn; gt = gtn;
        }
    }
}

#define XB_TMO      128
#define XB_XCNT(j)  (256  + 64 * (j))
#define XB_XCNT(j)  (256  + 64 * (j))
#define XB_XSUB(j)  (1280 + 64 * (j))
#define XB_XGEN(j)  (2304 + 64 * (j))
#define XB_TOP      3328
#define XB_TOPGEN   3392
#define XCD_BAR_WORDS 3456
#define XB_SPIN_CAP (1u << 18)

__device__ __forceinline__ unsigned xb_ld(unsigned* p)              { return __hip_atomic_load(p, __ATOMIC_RELAXED, __HIP_MEMORY_SCOPE_AGENT); }
__device__ __forceinline__ unsigned xb_add(unsigned* p, unsigned v) { return __hip_atomic_fetch_add(p, v, __ATOMIC_RELAXED, __HIP_MEMORY_SCOPE_AGENT); }
__device__ __forceinline__ unsigned xb_xcc_id() { return (unsigned)__builtin_amdgcn_s_getreg((3 << 11) | 20) & 0xFu; }
#define XB_SPIN(cond, bar) do { unsigned _sp = 0; while (cond) { __builtin_amdgcn_s_sleep(1); \
    if ((++_sp & 255u) == 0u) { if (xb_ld(&(bar)[XB_TMO])) break; if (_sp > XB_SPIN_CAP) { atomicAdd(&(bar)[XB_TMO], 1u); break; } } } } while (0)

struct XcdBarrier {
    unsigned* bar; unsigned x;
    volatile LAS unsigned* st;
};

__device__ __forceinline__ XcdBarrier xcd_barrier_post(unsigned* bar, volatile LAS unsigned* st) {
    XcdBarrier b; b.bar = bar; b.x = xb_xcc_id(); b.st = st;
    if (threadIdx.x == 0) (void)xb_add(&bar[XB_XCNT(b.x)], 1u);
    return b;
}
__device__ __forceinline__ void xcd_barrier_complete(unsigned* bar, unsigned x, unsigned& nloc, unsigned& nx) {
    const unsigned G = gridDim.x * gridDim.y * gridDim.z;
    unsigned sum, cnt, mine, sp = 0u;
    for (;;) {
        sum = 0u; cnt = 0u; mine = 0u;
#pragma unroll
        for (unsigned j = 0; j < 16; ++j) { const unsigned c = xb_ld(&bar[XB_XCNT(j)]); sum += c; cnt += (c > 0u) ? 1u : 0u; mine = (j == x) ? c : mine; }
        if (sum == G) break;
        __builtin_amdgcn_s_sleep(1);
        if ((++sp & 255u) == 0u) { if (xb_ld(&bar[XB_TMO])) break; if (sp > XB_SPIN_CAP) { atomicAdd(&bar[XB_TMO], 1u); break; } }
    }
    nloc = mine > 0u ? mine : 1u; nx = cnt > 0u ? cnt : 1u;
}

__device__ __forceinline__ void xcd_barrier(const XcdBarrier& b) {
    asm volatile("s_waitcnt vmcnt(0)" ::: "memory");
    __syncthreads();
    if (threadIdx.x == 0) {
        unsigned* bar = b.bar;
        __builtin_amdgcn_s_waitcnt(0);
        unsigned nloc = b.st[0], nx = b.st[1];
        if (nloc == 0u) { xcd_barrier_complete(bar, b.x, nloc, nx); b.st[0] = nloc; b.st[1] = nx; }
        const unsigned old = xb_add(&bar[XB_XSUB(b.x)], 1u);
        const unsigned gen = old / nloc;
        if (old + 1u == (gen + 1u) * nloc) {
            __builtin_amdgcn_fence(__ATOMIC_RELEASE, "agent");
            asm volatile("s_waitcnt vmcnt(0)" ::: "memory");
            const unsigned og = xb_add(&bar[XB_TOP], 1u);
            const unsigned tg = og / nx;
            if (og + 1u == (tg + 1u) * nx) xb_add(&bar[XB_TOPGEN], 1u);
            else XB_SPIN(xb_ld(&bar[XB_TOPGEN]) == tg, bar);
            __builtin_amdgcn_fence(__ATOMIC_ACQUIRE, "agent");
            xb_add(&bar[XB_XGEN(b.x)], 1u);
            asm volatile("s_waitcnt vmcnt(0)" ::: "memory");
        } else {
            XB_SPIN(xb_ld(&bar[XB_XGEN(b.x)]) == gen, bar);
            __builtin_amdgcn_fence(__ATOMIC_ACQUIRE, "agent");
            asm volatile("s_waitcnt vmcnt(0)" ::: "memory");
        }
    }
    __syncthreads();
}


#define grid_sync_all(gb) xcd_barrier(gb)

__global__ void __launch_bounds__(NTHREADS, 2) fwd_megakernel(Params p) {
    extern __shared__ __attribute__((aligned(16))) unsigned char lds_raw[];
    LAS unsigned char* lds = (LAS unsigned char*)lds_raw;
    cg::grid_group grid = cg::this_grid();
    { volatile LAS unsigned* st0 = (volatile LAS unsigned*)(lds + MISC_OFF + 32); if (threadIdx.x < 2) st0[threadIdx.x] = 0u; }
    __syncthreads();
    XcdBarrier gb = xcd_barrier_post((unsigned*)(p.ws + WS_CTL + 1024), (volatile LAS unsigned*)(lds + MISC_OFF + 32));
    const int G = (int)gridDim.x, bx = (int)blockIdx.x;
    unsigned char* ws = p.ws;
    const float* x = p.in[0]; const float* ctx = p.in[2];
    const float* npre = p.in[6]; const float* npost = p.in[7];
    float* mod = (float*)(ws + WS_MOD);
    bf16_t* U = (bf16_t*)(ws + WS_U); bf16_t* H = (bf16_t*)(ws + WS_BIG); bf16_t* Y = (bf16_t*)(ws + WS_Y); bf16_t* P = (bf16_t*)(ws + WS_BIG);
    bf16_t* Pc = (bf16_t*)(ws + WS_FW); bf16_t* QO = (bf16_t*)(ws + WS_Q); bf16_t* Kn = (bf16_t*)(ws + WS_K); bf16_t* Vt = (bf16_t*)(ws + WS_VT);
    bf16_t* OHF = (bf16_t*)(ws + WS_OHF); bf16_t* OHB = (bf16_t*)(ws + WS_OHB);
    bf16_t* X1B = (bf16_t*)p.out;
    bf16_t* X2B = OHF;
    bf16_t* OM = U;
    bf16_t* YB = OHF;
    float* out = p.out;

    p0_prep(p, lds);
    asm volatile("s_waitcnt vmcnt(0) lgkmcnt(0)" ::: "memory");
    grid.sync();
    if (threadIdx.x < 64) { __builtin_amdgcn_fence(__ATOMIC_ACQUIRE, "agent"); asm volatile("s_waitcnt vmcnt(0)" ::: "memory"); }
    __syncthreads();
    norm_pass(nullptr, x, ctx, nullptr, mod, nullptr, 0, 0.f, nullptr, nullptr, npre + 0 * D, 0, 1, U, TT);
    grid_sync_all(gb);
    { pg8::Gemm g{U, (const bf16_t*)(ws + WS_FW), TT, 2 * DFF, D}; pg8::StaticOrder S; S.init(TT, 2 * DFF, G, bx);
      EpiSwiGLU E{H}; pg8::gemm_phase<EpiSwiGLU, pg8::StaticOrder, true, true>(lds, g, S, E); }
    grid_sync_all(gb);
    { pg8::Gemm g{H, (const bf16_t*)(ws + WS_FW + 11534336), TT, D, DFF}; pg8::StaticOrder S; S.init(TT, D, G, bx);
      EpiStore E{Y, D}; pg8::gemm_phase<EpiStore, pg8::StaticOrder, true, true>(lds, g, S, E); }
    grid_sync_all(gb);
    norm_pass(Y, x, ctx, nullptr, mod, npost + 0 * D, 2, 0.5f, nullptr, X1B, npre + 1 * D, 3, 4, U, TT);
    grid_sync_all(gb);
    { pg8::Gemm g{U, (const bf16_t*)(ws + WS_WIN), TT, DIN, D}; InOrder S; S.init(G, bx);
      EpiIn E{P, Pc, QO, Kn, Vt, p.in[12], p.in[13], (const float*)(ws + WS_LB), (const float*)(ws + WS_ROPE)};
      pg8::gemm_phase<EpiIn, InOrder, true, true>(lds, g, S, E); }
    grid_sync_all(gb);
    {
        for (int it = bx; it < 128; it += G) hgrn_item(it, P, Pc, OHF, OHB, lds);
        unsigned* ctl = (unsigned*)(ws + WS_CTL);
        const float att_cb = ((const float*)(ws + WS_ROPE))[2048]; const bool att_bounded = att_cb <= 30.0f;
        if (att_bounded) attn_phase<true>(ctl, Kn, Vt, QO, OM, lds); else attn_phase<false>(ctl, Kn, Vt, QO, OM, lds);
    }
    grid_sync_all(gb);
    hg_out_pass(OHF, OHB, P, p.in[15], OM);
    grid_sync_all(gb);
    { pg8::Gemm g{OM, (const bf16_t*)(ws + WS_WAO), TL, D, D}; pg8::StaticOrder S; S.init(TL, D, G, bx);
      EpiMerge2 E{YB, P}; pg8::gemm_phase<EpiMerge2, pg8::StaticOrder, true, true>(lds, g, S, E); }
    grid_sync_all(gb);
    { pg8::Gemm g{YB, (const bf16_t*)(ws + WS_WO), TL, D, D}; pg8::StaticOrder S; S.init(TL, D, G, bx);
      EpiStore E{Y, D}; pg8::gemm_phase<EpiStore, pg8::StaticOrder, true, true>(lds, g, S, E); }
    transpose_jobs(p, 1, 3, (LAS float*)lds);
    grid_sync_all(gb);
    norm_pass(Y, nullptr, nullptr, X1B, mod, npost + 1 * D, 5, 1.0f, nullptr, X2B, npre + 2 * D, 6, 7, U, TL);
    grid_sync_all(gb);
    { pg8::Gemm g{U, (const bf16_t*)(ws + WS_Q), TL, 2 * DFF, D}; pg8::StaticOrder S; S.init(TL, 2 * DFF, G, bx);
      EpiSwiGLU E{H}; pg8::gemm_phase<EpiSwiGLU, pg8::StaticOrder, true, true>(lds, g, S, E); }
    grid_sync_all(gb);
    { pg8::Gemm g{H, (const bf16_t*)(ws + WS_Q + 11534336), TL, D, DFF}; pg8::StaticOrder S; S.init(TL, D, G, bx);
      EpiStore E{Y, D}; pg8::gemm_phase<EpiStore, pg8::StaticOrder, true, true>(lds, g, S, E); }
    grid_sync_all(gb);
    norm_pass(Y, nullptr, nullptr, X2B, mod, npost + 2 * D, 8, 0.5f, out, nullptr, nullptr, 0, 0, nullptr, TL);
}

extern "C" void kernel_launch(void* const* d_in, const int* in_sizes, int n_in, void* d_out, int out_size, void* d_ws, size_t ws_size, hipStream_t stream) {
    static int grid_blocks = 0;
    if (grid_blocks == 0) {
        int dev = 0, cus = 0, per_cu = 0;
        hipGetDevice(&dev);
        hipDeviceGetAttribute(&cus, hipDeviceAttributeMultiprocessorCount, dev);
        hipFuncSetAttribute((const void*)fwd_megakernel, hipFuncAttributeMaxDynamicSharedMemorySize, LDS_BYTES);
        hipOccupancyMaxActiveBlocksPerMultiprocessor(&per_cu, (const void*)fwd_megakernel, NTHREADS, LDS_BYTES);
        if (per_cu < 1) per_cu = 1;
        if (per_cu > 1) per_cu = 1;
        grid_blocks = cus * per_cu;
        if (ws_size < WS_END) fprintf(stderr, "kernel_launch: workspace too small: %zu < %zu\n", ws_size, (size_t)WS_END);
        (void)hipGetLastError();
    }
    (void)hipMemsetAsync((unsigned char*)d_ws + WS_CTL, 0, 16384, stream);
    Params p{};
    for (int i = 0; i < 19; ++i) p.in[i] = (const float*)d_in[i];
    p.out = (float*)d_out; p.ws = (unsigned char*)d_ws;
    void* args[] = {&p};
    hipError_t e = hipLaunchCooperativeKernel((const void*)fwd_megakernel, dim3(grid_blocks), dim3(NTHREADS), args, LDS_BYTES, stream);
    if (e != hipSuccess) fprintf(stderr, "cooperative launch failed: %s (grid %d)\n", hipGetErrorString(e), grid_blocks);
}
```

```cpp
#include <hip/hip_runtime.h>
#include <hip/hip_cooperative_groups.h>
#include <cstdio>
#include <cstdint>
namespace cg = cooperative_groups;
__device__ __forceinline__ int opaque_tid() { int t; asm volatile("v_mov_b32 %0, %1" : "=v"(t) : "v"((int)threadIdx.x)); return t; }
namespace pg8 {
#define PG8_LAS __attribute__((address_space(3)))
typedef unsigned short bf16_t;
typedef short bf16x8 __attribute__((ext_vector_type(8)));
typedef float f32x4 __attribute__((ext_vector_type(4)));
typedef unsigned u32x4 __attribute__((ext_vector_type(4)));
constexpr int BM = 256, BK = 64, HALF = 128, HTB = HALF * BK * 2  , STAGE_BYTES = 8 * HTB, NXCD = 8, WGM = 8;

__host__ __device__ __forceinline__ int lds_byte(int r, int c) { const int st = (r >> 4) * 2 + (c >> 5), rr = r & 15, cc = c & 31, ob = rr * 64 + cc * 2; return st * 1024 + (ob ^ (((ob >> 9) & 1) << 5)); }
__host__ __device__ __forceinline__ void stage_rc(int b, int& R, int& C) { const int st = b / 1024, sb = b % 1024, swz = sb ^ (((sb >> 9) & 1) << 5); R = (st >> 1) * 16 + swz / 64; C = (st & 1) * 32 + (swz % 64) / 2; }
__host__ __device__ __forceinline__ int perm32(int rho) { const int n = rho >> 4, i = rho & 15; return 8 * (i >> 2) + 4 * n + (i & 3); }

struct Unit { int pm, pn; };
struct Gemm { const bf16_t* A; const bf16_t* Bt; int M, N, K; };

struct StaticOrder {
    int nM, nN, nwg, G, c;
    __host__ __device__ void init(int M, int N, int G_, int c_) { nM = M / BM; nN = N / BM; nwg = nM * nN; G = G_; c = c_; }
    __host__ __device__ bool next(int i, Unit& u) const {
        const long L = (long)i * G + c; if (L >= nwg) return false;
        int wgid = (int)L; { const int q = nwg / NXCD, r = nwg % NXCD, xcd = wgid % NXCD, off = wgid / NXCD; wgid = (xcd < r ? xcd * (q + 1) : r * (q + 1) + (xcd - r) * q) + off; }
        const int nig = WGM * nN, gid = wgid / nig, fm = gid * WGM, gsz = (nM - fm) < WGM ? (nM - fm) : WGM;
        u.pm = fm + ((wgid % nig) % gsz); u.pn = (wgid % nig) / gsz; return true;
    }
    __device__ __forceinline__ void a_ready(const Unit&) const {}
    __device__ __forceinline__ void done(const Unit&) const {}
};

__device__ __forceinline__ unsigned cvt_pk_bf16(float lo, float hi) { unsigned r; asm volatile("v_cvt_pk_bf16_f32 %0, %1, %2" : "=v"(r) : "v"(lo), "v"(hi)); return r; }
template <class Epi, class Sched, bool ALIGN_EPI = false, bool SP2 = false>
__device__ __forceinline__ void gemm_phase(PG8_LAS unsigned char* lds, const Gemm g, const Sched& S, const Epi& E) {
    const int tid = opaque_tid(), wid = __builtin_amdgcn_readfirstlane(tid >> 6), lane = tid & 63, wr = wid >> 2, wc = wid & 3, fr = lane & 15, fq = lane >> 4;
    const int K = g.K, nt = K / BK;
    unsigned voffA[2], voffB[2];
#pragma unroll
    for (int i = 0; i < 2; ++i) { int R, C; stage_rc(tid * 16 + i * 8192, R, C); const int Rb = Epi::PERM ? ((R & ~31) + perm32(R & 31)) : R;
        voffA[i] = (unsigned)(R * K + C) * 2u; voffB[i] = (unsigned)(Rb * K + C) * 2u; }
    const size_t kstep = (size_t)(BK * 2);
    const size_t hstep = (size_t)HALF * K * 2;
    const size_t tstep = 2 * hstep;
    const unsigned ldsw = (unsigned)wid * 1024u;
    const int aoff = lds_byte(wr * 64 + fr, fq * 8), boff = lds_byte(wc * 32 + fr, fq * 8);
#define PG8_SA(b, h) (((b) * 2 + (h)) * HTB)
#define PG8_SB(b, h) ((4 + (b) * 2 + (h)) * HTB)
#define PG8_STAGE(bufoff, gbase, voff) do { _Pragma("unroll") for (int _i = 0; _i < 2; ++_i) \
        __builtin_amdgcn_global_load_lds((const unsigned*)((const char*)(gbase) + (voff)[_i]), (PG8_LAS unsigned*)(lds + (bufoff) + ldsw + _i * 8192), 16, 0, 0); } while (0)
#define PG8_LDA(dst, b, h) do { _Pragma("unroll") for (int m = 0; m < 4; ++m) _Pragma("unroll") for (int k = 0; k < 2; ++k) dst[m][k] = *(const PG8_LAS bf16x8*)(lds + PG8_SA(b, h) + aoff + m * 2048 + k * 1024); } while (0)
#define PG8_LDB(dst, b, h) do { _Pragma("unroll") for (int n = 0; n < 2; ++n) _Pragma("unroll") for (int k = 0; k < 2; ++k) dst[n][k] = *(const PG8_LAS bf16x8*)(lds + PG8_SB(b, h) + boff + n * 2048 + k * 1024); } while (0)
#define PG8_MMA(ai, bj, At, Bt) do { __builtin_amdgcn_s_setprio(1); _Pragma("unroll") for (int m = 0; m < 4; ++m) _Pragma("unroll") for (int n = 0; n < 2; ++n) _Pragma("unroll") for (int k = 0; k < 2; ++k) \
        acc[ai][bj][m][n] = __builtin_amdgcn_mfma_f32_16x16x32_bf16(Bt[n][k], At[m][k], acc[ai][bj][m][n], 0, 0, 0); __builtin_amdgcn_s_setprio(0); } while (0)
#define PG8_WAIT_V(n) asm volatile("s_waitcnt vmcnt(" #n ")" ::: "memory")
#define PG8_WAIT_L(n) asm volatile("s_waitcnt lgkmcnt(" #n ")" ::: "memory")
#define PG8_BAR __builtin_amdgcn_s_barrier()
#define PG8_SCHED __builtin_amdgcn_sched_barrier(0)
    Unit cur, nxt; int ui = 0;
    if (!S.next(0, cur)) return;
    f32x4 acc[2][2][4][2];
#pragma unroll
    for (int a = 0; a < 2; ++a)
#pragma unroll
        for (int b = 0; b < 2; ++b)
#pragma unroll
            for (int m = 0; m < 4; ++m)
#pragma unroll
                for (int n = 0; n < 2; ++n) acc[a][b][m][n] = (f32x4){0.f, 0.f, 0.f, 0.f};
    bf16x8 At[4][2], B0[2][2], B1[2][2];
    const char* cA = (const char*)g.A + (size_t)cur.pm * tstep; const char* cB = (const char*)g.Bt + (size_t)cur.pn * tstep;
    S.a_ready(cur);
    if constexpr (SP2) {
        PG8_STAGE(PG8_SB(0, 0), cB, voffB); PG8_STAGE(PG8_SB(0, 1), cB + hstep, voffB); PG8_STAGE(PG8_SA(0, 0), cA, voffA); PG8_STAGE(PG8_SA(0, 1), cA + hstep, voffA);
        if (wr == 1) PG8_BAR;
        PG8_WAIT_V(2); PG8_BAR;
        PG8_STAGE(PG8_SB(1, 0), cB + kstep, voffB); PG8_STAGE(PG8_SA(1, 0), cA + kstep, voffA); PG8_STAGE(PG8_SB(1, 1), cB + hstep + kstep, voffB);
        PG8_WAIT_V(6); PG8_BAR;
    } else {
        PG8_STAGE(PG8_SB(0, 0), cB, voffB); PG8_STAGE(PG8_SA(0, 0), cA, voffA); PG8_STAGE(PG8_SB(0, 1), cB + hstep, voffB); PG8_STAGE(PG8_SA(0, 1), cA + hstep, voffA);
        if (wr == 1) PG8_BAR;
        PG8_WAIT_V(4); PG8_BAR;
        PG8_STAGE(PG8_SB(1, 0), cB + kstep, voffB); PG8_STAGE(PG8_SA(1, 0), cA + kstep, voffA); PG8_STAGE(PG8_SB(1, 1), cB + hstep + kstep, voffB);
        PG8_WAIT_V(6); PG8_BAR;
    }
    for (;;) {
        const bool has_next = S.next(ui + 1, nxt);
        const char* nA = has_next ? (const char*)g.A + (size_t)nxt.pm * tstep : cA; const char* nB = has_next ? (const char*)g.Bt + (size_t)nxt.pn * tstep : cB;
        for (int t = 0; t < nt; t += 2) {
            const bool last = (t == nt - 2);
            if constexpr (Epi::HAS_MID) { if (t == (nt >> 1)) E.mid(acc, cur, wr, wc, fr, fq); }
            const char* a1 = cA + (size_t)(t + 1) * kstep;
            const char* a2 = last ? nA : cA + (size_t)(t + 2) * kstep; const char* b2 = last ? nB : cB + (size_t)(t + 2) * kstep;
            const char* a3 = a2 + kstep; const char* b3 = b2 + kstep;
            if (last && has_next) S.a_ready(nxt);
            if constexpr (SP2) {
            PG8_LDB(B0, 0, 0); PG8_LDB(B1, 0, 1); PG8_SCHED; PG8_LDA(At, 0, 0); PG8_STAGE(PG8_SA(1, 1), a1 + hstep, voffA);
            PG8_WAIT_V(8); PG8_WAIT_L(0); PG8_BAR; PG8_MMA(0, 0, At, B0); PG8_MMA(0, 1, At, B1); PG8_BAR; PG8_SCHED;
            PG8_LDA(At, 0, 1); PG8_STAGE(PG8_SB(0, 0), b2, voffB); PG8_STAGE(PG8_SB(0, 1), b2 + hstep, voffB); PG8_STAGE(PG8_SA(0, 0), a2, voffA);
            PG8_WAIT_V(8); PG8_WAIT_L(0); PG8_BAR; PG8_MMA(1, 0, At, B0); PG8_MMA(1, 1, At, B1); PG8_BAR; PG8_SCHED;
            PG8_LDB(B0, 1, 0); PG8_LDB(B1, 1, 1); PG8_SCHED; PG8_LDA(At, 1, 0); PG8_STAGE(PG8_SA(0, 1), a2 + hstep, voffA);
            PG8_WAIT_V(8); PG8_WAIT_L(0); PG8_BAR; PG8_MMA(0, 0, At, B0); PG8_MMA(0, 1, At, B1); PG8_BAR; PG8_SCHED;
            PG8_LDA(At, 1, 1); PG8_STAGE(PG8_SB(1, 0), b3, voffB); PG8_STAGE(PG8_SB(1, 1), b3 + hstep, voffB); PG8_STAGE(PG8_SA(1, 0), a3, voffA);
            PG8_WAIT_V(8); PG8_WAIT_L(0); PG8_BAR; PG8_MMA(1, 0, At, B0); PG8_MMA(1, 1, At, B1); PG8_BAR; PG8_SCHED;
            } else {
            PG8_LDB(B0, 0, 0); PG8_SCHED; PG8_LDA(At, 0, 0); PG8_STAGE(PG8_SA(1, 1), a1 + hstep, voffA);
            PG8_WAIT_L(8); PG8_BAR; PG8_WAIT_L(0); PG8_MMA(0, 0, At, B0); PG8_BAR; PG8_SCHED;
            PG8_LDB(B1, 0, 1); PG8_STAGE(PG8_SB(0, 0), b2, voffB);
            PG8_BAR; PG8_WAIT_L(0); PG8_MMA(0, 1, At, B1); PG8_BAR;
            PG8_LDA(At, 0, 1); PG8_STAGE(PG8_SA(0, 0), a2, voffA);
            PG8_BAR; PG8_WAIT_L(0); PG8_MMA(1, 0, At, B0); PG8_BAR; PG8_SCHED;
            PG8_STAGE(PG8_SB(0, 1), b2 + hstep, voffB);
            PG8_WAIT_V(6); PG8_BAR; PG8_MMA(1, 1, At, B1); PG8_BAR;
            PG8_LDB(B0, 1, 0); PG8_SCHED; PG8_LDA(At, 1, 0); PG8_STAGE(PG8_SA(0, 1), a2 + hstep, voffA);
            PG8_WAIT_L(8); PG8_BAR; PG8_WAIT_L(0); PG8_MMA(0, 0, At, B0); PG8_BAR; PG8_SCHED;
            PG8_LDB(B1, 1, 1); PG8_STAGE(PG8_SB(1, 0), b3, voffB);
            PG8_BAR; PG8_WAIT_L(0); PG8_MMA(0, 1, At, B1); PG8_BAR;
            PG8_LDA(At, 1, 1); PG8_STAGE(PG8_SA(1, 0), a3, voffA);
            PG8_BAR; PG8_WAIT_L(0); PG8_MMA(1, 0, At, B0); PG8_BAR; PG8_SCHED;
            PG8_STAGE(PG8_SB(1, 1), b3 + hstep, voffB);
            PG8_WAIT_V(6); PG8_BAR; PG8_MMA(1, 1, At, B1); PG8_BAR;
            }
        }
        if constexpr (ALIGN_EPI) { if (wr == 0) PG8_BAR; }
        if constexpr (!Epi::AFTER_DRAIN) { E(acc, cur, wr, wc, fr, fq); S.done(cur); }
        if (!has_next) break;
#pragma unroll
        for (int a = 0; a < 2; ++a)
#pragma unroll
            for (int b = 0; b < 2; ++b)
#pragma unroll
                for (int m = 0; m < 4; ++m)
#pragma unroll
                    for (int n = 0; n < 2; ++n) acc[a][b][m][n] = (f32x4){0.f, 0.f, 0.f, 0.f};
        cur = nxt; cA = nA; cB = nB; ++ui;
        if constexpr (ALIGN_EPI) { if (wr == 1) PG8_BAR; }
    }
    PG8_WAIT_V(0);
    if constexpr (!ALIGN_EPI) { if (wr == 0) PG8_BAR; }
    PG8_BAR;
    if constexpr (Epi::AFTER_DRAIN) { E.fused(acc, cur, wr, wc, fr, fq, lds, wid, lane); S.done(cur); }
#undef PG8_SA
#undef PG8_SB
#undef PG8_STAGE
#undef PG8_LDA
#undef PG8_LDB
#undef PG8_MMA
#undef PG8_WAIT_V
#undef PG8_WAIT_L
#undef PG8_BAR
#undef PG8_SCHED
}
}

#define LAS __attribute__((address_space(3)))
typedef unsigned short bf16_t;
typedef short bf16x8 __attribute__((ext_vector_type(8)));
typedef float f32x4 __attribute__((ext_vector_type(4)));
typedef float f32x16 __attribute__((ext_vector_type(16)));
typedef unsigned u32x4 __attribute__((ext_vector_type(4)));
typedef unsigned u32x2 __attribute__((ext_vector_type(2)));
using pg8::Unit;

constexpr int D = 1024, NB = 16, SEQ = 2048, CTXL = 256, TL = NB * SEQ, TC = NB * CTXL, TT = TL + TC, DFF = 2816, DIN = 5376, NMOD = 9;
constexpr int PW = 4608, PCW = 1536, NKEY = SEQ + CTXL;
constexpr float EPS = 1e-6f;
constexpr int NTHREADS = 512;
constexpr int LDS_BYTES = 153600 + 1024;
constexpr int MISC_OFF = 153600;

constexpr size_t MiB = 1048576;
constexpr size_t WS_MOD = 0;
constexpr size_t WS_LB = 768 * 1024;
constexpr size_t WS_ROPE = 800 * 1024;
constexpr size_t WS_CTL = 900 * 1024;
constexpr size_t WS_WIN = 1 * MiB;
constexpr size_t WS_WAO = WS_WIN + 11010048;
constexpr size_t WS_WHO = WS_WAO + 1 * MiB;
constexpr size_t WS_WO = WS_WHO + 1 * MiB;
constexpr size_t WS_FW = WS_WO + 2 * MiB;
constexpr size_t WS_U = 32 * MiB;
constexpr size_t WS_BIG = 104 * MiB;
constexpr size_t WS_Y = WS_BIG + 198 * MiB;
constexpr size_t WS_Q = 392 * MiB;
constexpr size_t WS_K = 424 * MiB;
constexpr size_t WS_VT = 433 * MiB;
constexpr size_t WS_OHF = 442 * MiB;
constexpr size_t WS_OHB = 474 * MiB;
constexpr size_t WS_END = 506 * MiB;
static_assert(WS_FW + 11534336 + 5767168 <= WS_U, "ws map");
static_assert(WS_WIN + 11010048 == WS_WAO, "ws map");

typedef float f32x2_t __attribute__((ext_vector_type(2)));
typedef __bf16 bf16x2_t __attribute__((ext_vector_type(2)));
__device__ __forceinline__ unsigned pk2(float lo, float hi) { const f32x2_t v = {lo, hi}; const bf16x2_t b = __builtin_convertvector(v, bf16x2_t); return __builtin_bit_cast(unsigned, b); }
__device__ __forceinline__ float bflo(unsigned u) { return __uint_as_float(u << 16); }
__device__ __forceinline__ float bfhi(unsigned u) { return __uint_as_float(u & 0xffff0000u); }
__device__ __forceinline__ float sigmoidf_(float x) { return __builtin_amdgcn_rcpf(1.0f + __builtin_amdgcn_exp2f(-1.4426950408889634f * x)); }
__device__ __forceinline__ float siluf_(float x) { return x * sigmoidf_(x); }
__device__ __forceinline__ unsigned pkh2(float lo, float hi) {
    const unsigned a = (unsigned)__builtin_bit_cast(unsigned short, (_Float16)lo), b = (unsigned)__builtin_bit_cast(unsigned short, (_Float16)hi);
    return a | (b << 16);
}
__device__ __forceinline__ float hlo(unsigned u) { return (float)__builtin_bit_cast(_Float16, (unsigned short)(u & 0xffffu)); }
__device__ __forceinline__ float hhi(unsigned u) { return (float)__builtin_bit_cast(_Float16, (unsigned short)(u >> 16)); }
__device__ __forceinline__ float wave_sum(float v) {
#pragma unroll
    for (int o = 32; o >= 1; o >>= 1) v += __shfl_xor(v, o);
    return v;
}


struct Params {
    const float* in[19];
    float* out;
    unsigned char* ws;
};

__device__ __forceinline__ int map_row(int mode, int n) {
    if (mode == 1) { if (n < 768) { const int tile = n >> 8, w = n & 255, wcq = w >> 6, rem = w & 63, bj = rem >> 5, i = rem & 31; return (tile << 8) + (bj << 7) + (wcq << 5) + i; } return n; }
    if (mode == 2) return ((n >> 7) << 8) + (n & 127);
    if (mode == 3) return ((n >> 7) << 8) + 128 + (n & 127);
    return n;
}
__device__ __forceinline__ void transpose_tile(const float* __restrict__ src, int K, int N, bf16_t* __restrict__ dst, int ld, int mode, int tk, int tn, LAS float* scr) {
    const int tid = opaque_tid();
#pragma unroll
    for (int p = 0; p < 8; ++p) { const int kr = p * 8 + (tid >> 6), nc = tid & 63; scr[nc * 65 + kr] = src[(size_t)(tk * 64 + kr) * N + tn * 64 + nc]; }
    __syncthreads();
    { const int n = tid >> 3, ch = tid & 7; const int nm = map_row(mode, tn * 64 + n);
      float v[8];
#pragma unroll
      for (int j = 0; j < 8; ++j) v[j] = scr[n * 65 + ch * 8 + j];
      u32x4 w; w.x = pk2(v[0], v[1]); w.y = pk2(v[2], v[3]); w.z = pk2(v[4], v[5]); w.w = pk2(v[6], v[7]);
      *(u32x4*)(dst + (size_t)nm * ld + tk * 64 + ch * 8) = w; }
    __syncthreads();
}
struct TJob { const float* src; int K, N; bf16_t* dst; int mode; int ld, koff; };
__device__ __forceinline__ TJob get_job(const Params& p, int set, int j) {
    unsigned char* ws = p.ws;
    if (set == 0) {
        switch (j) {
            case 0: return TJob{p.in[11], D, DIN, (bf16_t*)(ws + WS_WIN), 1, D, 0};
            case 1: return TJob{p.in[8], D, DFF, (bf16_t*)(ws + WS_FW), 2, D, 0};
            case 2: return TJob{p.in[9], D, DFF, (bf16_t*)(ws + WS_FW), 3, D, 0};
            case 3: return TJob{p.in[10], DFF, D, (bf16_t*)(ws + WS_FW + 11534336), 0, DFF, 0};
            case 4: return TJob{p.in[16], 512, D, (bf16_t*)(ws + WS_WAO), 0, 1024, 0};
            case 5: return TJob{p.in[17], 512, D, (bf16_t*)(ws + WS_WAO), 0, 1024, 512};
            default: return TJob{p.in[18], D, D, (bf16_t*)(ws + WS_WO), 0, D, 0};
        }
    }
    switch (j) {
        case 0: return TJob{p.in[8] + (size_t)D * DFF, D, DFF, (bf16_t*)(ws + WS_Q), 2, D, 0};
        case 1: return TJob{p.in[9] + (size_t)D * DFF, D, DFF, (bf16_t*)(ws + WS_Q), 3, D, 0};
        default: return TJob{p.in[10] + (size_t)D * DFF, DFF, D, (bf16_t*)(ws + WS_Q + 11534336), 0, DFF, 0};
    }
}
__device__ __forceinline__ void transpose_jobs(const Params& p, int set, int njobs, LAS float* scr) {
    int total = 0;
    for (int j = 0; j < njobs; ++j) { const TJob jb = get_job(p, set, j); total += (jb.K >> 6) * (jb.N >> 6); }
    const int G = (int)gridDim.x, bx = (int)blockIdx.x;
    const bool weighted = (set == 0) && (G > 144);
    const int nw = weighted ? 144 + 2 * (G - 144) : G;
    const int w0 = weighted ? (bx < 144 ? bx : 144 + 2 * (bx - 144)) : bx;
    const int nmine = (weighted && bx >= 144) ? 2 : 1;
    for (int k = 0; k < nmine; ++k)
    for (int t = w0 + k; t < total; t += nw) {
        int r = t, j = 0;
        for (; j < njobs - 1; ++j) { const TJob jb = get_job(p, set, j); const int c = (jb.K >> 6) * (jb.N >> 6); if (r < c) break; r -= c; }
        const TJob jb = get_job(p, set, j);
        const int ntn = jb.N >> 6;
        transpose_tile(jb.src, jb.K, jb.N, jb.dst + jb.koff, jb.ld, jb.mode, r / ntn, r % ntn, scr);
    }
}

__device__ __forceinline__ void mod_task(const Params& p, int ct, LAS float* lds) {
    const float* c = p.in[1]; const float* cctx = p.in[3]; const float* wm = p.in[4]; const float* bm = p.in[5];
    float* mod = (float*)(p.ws + WS_MOD);
    LAS float* sc = lds;
    LAS float* red = lds + 1024 * 20;
    const int tid = opaque_tid();
    for (int e = tid; e < 17 * 1024; e += NTHREADS) { const int i = e >> 10, k = e & 1023; const float v = (i < 16) ? c[i * 1024 + k] : cctx[k]; sc[k * 20 + i] = siluf_(v); }
    __syncthreads();
    const int col = tid & 63, ks = tid >> 6;
    float acc[17];
#pragma unroll
    for (int i = 0; i < 17; ++i) acc[i] = 0.f;
    const float* wp = wm + (size_t)(ks * 128) * (NMOD * D) + ct * 64 + col;
#pragma unroll 16
    for (int k = 0; k < 128; ++k) {
        const float w = wp[(size_t)k * (NMOD * D)];
        const LAS f32x4* s4 = (const LAS f32x4*)(sc + (ks * 128 + k) * 20);
        const f32x4 a = s4[0], b = s4[1], cc = s4[2], d = s4[3]; const float e = sc[(ks * 128 + k) * 20 + 16];
        acc[0] += a[0] * w; acc[1] += a[1] * w; acc[2] += a[2] * w; acc[3] += a[3] * w;
        acc[4] += b[0] * w; acc[5] += b[1] * w; acc[6] += b[2] * w; acc[7] += b[3] * w;
        acc[8] += cc[0] * w; acc[9] += cc[1] * w; acc[10] += cc[2] * w; acc[11] += cc[3] * w;
        acc[12] += d[0] * w; acc[13] += d[1] * w; acc[14] += d[2] * w; acc[15] += d[3] * w;
        acc[16] += e * w;
    }
#pragma unroll
    for (int i = 0; i < 17; ++i) red[(ks * 17 + i) * 64 + col] = acc[i];
    __syncthreads();
    for (int e = tid; e < 17 * 64; e += NTHREADS) {
        const int i = e >> 6, cl = e & 63; float s = 0.f;
#pragma unroll
        for (int q = 0; q < 8; ++q) s += red[(q * 17 + i) * 64 + cl];
        mod[i * (NMOD * D) + ct * 64 + cl] = s + bm[ct * 64 + cl];
    }
    __syncthreads();
}

__device__ __forceinline__ void p0_prep(const Params& p, LAS unsigned char* lds) {
    LAS float* fl = (LAS float*)lds;
    const int tid = opaque_tid();
    for (int t = (int)blockIdx.x; t < 144; t += (int)gridDim.x) mod_task(p, t, fl);
    if (blockIdx.x == gridDim.x - 1) {
        float* lb = (float*)(p.ws + WS_LB); const float* hlb = p.in[14];
        for (int e = tid; e < 1024; e += NTHREADS) { const int dir = e >> 9, ch = e & 511; const float a0 = hlb[dir * 1024 + ch], a1 = hlb[dir * 1024 + 512 + ch]; lb[e] = 1.0f / (1.0f + __expf(a1 - a0)); }
        if (tid == 0) {
            float mq = 0.f, mk = 0.f;
            for (int i = 0; i < 64; ++i) { mq = fmaxf(mq, fabsf(p.in[12][i])); mk = fmaxf(mk, fabsf(p.in[13][i])); }
            ((float*)(p.ws + WS_ROPE))[2048] = 64.0f * mq * mk * (0.125f * 1.4426950408889634f) * 1.02f;
        }
        float* rope = (float*)(p.ws + WS_ROPE);
        for (int e = tid; e < 1024; e += NTHREADS) { const int pos = e >> 4, pp = e & 15; const float inv = exp2f(-(float)pp * (13.287712379549449f / 16.0f)); const float ang = (float)pos * inv;
            rope[e * 2] = __cosf(ang); rope[e * 2 + 1] = __sinf(ang); }

    }
    transpose_jobs(p, 0, 7, fl);
}

#define NP_LOAD(R, HH, YY, XX) do { const int r_ = (R); \
    if (hb) { _Pragma("unroll") for (int i = 0; i < 4; ++i) XX[i] = *(const u32x2*)(hb + (size_t)r_ * D + 256 * i + 4 * lane); } \
    else { const float* hrow_ = (r_ < TL) ? hx + (size_t)r_ * D : hc + (size_t)(r_ - TL) * D; \
        _Pragma("unroll") for (int i = 0; i < 4; ++i) HH[i] = *(const f32x4*)(hrow_ + 256 * i + 4 * lane); } \
    if (Y) { _Pragma("unroll") for (int i = 0; i < 4; ++i) YY[i] = *(const u32x2*)(Y + (size_t)r_ * D + 256 * i + 4 * lane); } } while (0)
#define NP_BODY(R, HH, YY, XX) do { const int r_ = (R); \
    const int bi_ = (r_ < TL) ? (r_ >> 11) : 16; \
    if (hb) { _Pragma("unroll") for (int i = 0; i < 4; ++i) HH[i] = (f32x4){bflo(XX[i].x), bfhi(XX[i].x), bflo(XX[i].y), bfhi(XX[i].y)}; } \
    if (bi_ != curb) { curb = bi_; const float* mrow = mod + bi_ * (NMOD * D); \
        _Pragma("unroll") for (int i = 0; i < 4; ++i) { if (Y) gt[i] = *(const f32x4*)(mrow + gate_idx * D + 256 * i + 4 * lane); \
            if (U) { sh[i] = *(const f32x4*)(mrow + shift_idx * D + 256 * i + 4 * lane); sc[i] = *(const f32x4*)(mrow + scale_idx * D + 256 * i + 4 * lane) + 1.0f; } } } \
    if (Y) { f32x4 y[4]; float ss = 0.f; \
        _Pragma("unroll") for (int i = 0; i < 4; ++i) { y[i] = (f32x4){bflo(YY[i].x), bfhi(YY[i].x), bflo(YY[i].y), bfhi(YY[i].y)}; \
            ss += y[i][0] * y[i][0] + y[i][1] * y[i][1] + y[i][2] * y[i][2] + y[i][3] * y[i][3]; } \
        ss = wave_sum(ss); const float rstd = rsqrtf(ss * (1.0f / D) + EPS) * coef; \
        _Pragma("unroll") for (int i = 0; i < 4; ++i) HH[i] += gt[i] * (y[i] * rstd * gpo[i]); } \
    if (hob && r_ < TL) { _Pragma("unroll") for (int i = 0; i < 4; ++i) { u32x2 w; w.x = pk2(HH[i][0], HH[i][1]); w.y = pk2(HH[i][2], HH[i][3]); \
        *(u32x2*)(hob + (size_t)r_ * D + 256 * i + 4 * lane) = w; \
        HH[i] = (f32x4){bflo(w.x), bfhi(w.x), bflo(w.y), bfhi(w.y)}; } }     \
    if (hout && r_ < TL) { _Pragma("unroll") for (int i = 0; i < 4; ++i) *(f32x4*)(hout + (size_t)r_ * D + 256 * i + 4 * lane) = HH[i]; } \
    if (U) { float ss = 0.f; \
        _Pragma("unroll") for (int i = 0; i < 4; ++i) ss += HH[i][0] * HH[i][0] + HH[i][1] * HH[i][1] + HH[i][2] * HH[i][2] + HH[i][3] * HH[i][3]; \
        ss = wave_sum(ss); const float rstd = rsqrtf(ss * (1.0f / D) + EPS); \
        _Pragma("unroll") for (int i = 0; i < 4; ++i) { const f32x4 u = (HH[i] * rstd * gpr[i]) * sc[i] + sh[i]; \
            u32x2 w; w.x = pk2(u[0], u[1]); w.y = pk2(u[2], u[3]); *(u32x2*)(U + (size_t)r_ * D + 256 * i + 4 * lane) = w; } } } while (0)
__device__ __forceinline__ void norm_pass(const bf16_t* __restrict__ Y, const float* hx, const float* hc, const bf16_t* hb, const float* __restrict__ mod,
                                          const float* __restrict__ gpost, int gate_idx, float coef, float* hout, bf16_t* hob,
                                          const float* __restrict__ gpre, int shift_idx, int scale_idx, bf16_t* __restrict__ U, int nrows) {
    const int tid_ = opaque_tid(); const int lane = tid_ & 63, wave = tid_ >> 6;
    const int W = (int)gridDim.x * 8, gw = (int)blockIdx.x * 8 + wave;
    const int rpw = (((nrows + W - 1) / W) + 1) & ~1;
    const int r0 = gw * rpw, r1 = (r0 + rpw < nrows) ? r0 + rpw : nrows;
    if (r0 < r1) {
        f32x4 gpo[4], gpr[4], gt[4], sh[4], sc[4];
#pragma unroll
        for (int i = 0; i < 4; ++i) { gpo[i] = Y ? *(const f32x4*)(gpost + 256 * i + 4 * lane) : (f32x4){0.f, 0.f, 0.f, 0.f}; gpr[i] = U ? *(const f32x4*)(gpre + 256 * i + 4 * lane) : (f32x4){0.f, 0.f, 0.f, 0.f};
            gt[i] = sh[i] = sc[i] = (f32x4){0.f, 0.f, 0.f, 0.f}; }
        int curb = -1;
        f32x4 hA[4], hB[4]; u32x2 yA[4], yB[4], xA[4], xB[4];
#pragma unroll
        for (int i = 0; i < 4; ++i) { yA[i] = yB[i] = xA[i] = xB[i] = (u32x2){0u, 0u}; hA[i] = hB[i] = (f32x4){0.f, 0.f, 0.f, 0.f}; }
        NP_LOAD(r0, hA, yA, xA);
        if (r0 + 1 < r1) NP_LOAD(r0 + 1, hB, yB, xB);
        for (int r = r0; r < r1; r += 2) {
            f32x4 hAn[4], hBn[4]; u32x2 yAn[4], yBn[4], xAn[4], xBn[4];
#pragma unroll
            for (int i = 0; i < 4; ++i) { hAn[i] = hBn[i] = (f32x4){0.f, 0.f, 0.f, 0.f}; yAn[i] = yBn[i] = xAn[i] = xBn[i] = (u32x2){0u, 0u}; }
            if (r + 2 < r1) NP_LOAD(r + 2, hAn, yAn, xAn);
            if (r + 3 < r1) NP_LOAD(r + 3, hBn, yBn, xBn);
            NP_BODY(r, hA, yA, xA);
            if (r + 1 < r1) NP_BODY(r + 1, hB, yB, xB);
#pragma unroll
            for (int i = 0; i < 4; ++i) { hA[i] = hAn[i]; yA[i] = yAn[i]; xA[i] = xAn[i]; hB[i] = hBn[i]; yB[i] = yBn[i]; xB[i] = xBn[i]; }
        }
    }
}

struct InOrder {
    pg8::StaticOrder so;
    __device__ void init(int G, int c) { so.init(TL, DIN, G, c); }
    __device__ bool next(int i, Unit& u) const {
        const long L = (long)i * so.G + so.c;
        if (L < so.nwg) return so.next(i, u);
        const int e = (int)(L - so.nwg); if (e >= 112) return false;
        const int pi = e >> 4; u.pm = 128 + (e & 15); u.pn = (pi == 0) ? 2 : (4 + pi); return true;
    }
    __device__ __forceinline__ void a_ready(const Unit&) const {}
    __device__ __forceinline__ void done(const Unit&) const {}
};

struct EpiSwiGLU {
    static constexpr bool PERM = true, AFTER_DRAIN = false, HAS_MID = false;
    bf16_t* H;
    __device__ __forceinline__ void operator()(const f32x4 (&acc)[2][2][4][2], const Unit& u, int wr, int wc, int fr, int fq) const {
        const int row0 = u.pm * 256 + wr * 64 + fr, col0 = u.pn * 128 + wc * 32 + 8 * fq;
#pragma unroll
        for (int ai = 0; ai < 2; ++ai)
#pragma unroll
            for (int m = 0; m < 4; ++m) {
                float v[8];
#pragma unroll
                for (int n = 0; n < 2; ++n)
#pragma unroll
                    for (int j = 0; j < 4; ++j) v[n * 4 + j] = siluf_(acc[ai][0][m][n][j]) * acc[ai][1][m][n][j];
                u32x4 w; w.x = pk2(v[0], v[1]); w.y = pk2(v[2], v[3]); w.z = pk2(v[4], v[5]); w.w = pk2(v[6], v[7]);
                *(u32x4*)(H + (size_t)(row0 + ai * 128 + m * 16) * DFF + col0) = w;
            }
    }
};
struct EpiStore {
    static constexpr bool PERM = true, AFTER_DRAIN = false, HAS_MID = false;
    bf16_t* O; int ldc;
    __device__ __forceinline__ void operator()(const f32x4 (&acc)[2][2][4][2], const Unit& u, int wr, int wc, int fr, int fq) const {
        const int row0 = u.pm * 256 + wr * 64 + fr, col0 = u.pn * 256 + wc * 32 + 8 * fq;
#pragma unroll
        for (int ai = 0; ai < 2; ++ai)
#pragma unroll
            for (int m = 0; m < 4; ++m)
#pragma unroll
                for (int bj = 0; bj < 2; ++bj) {
                    const f32x4 a = acc[ai][bj][m][0], b = acc[ai][bj][m][1];
                    u32x4 w; w.x = pk2(a[0], a[1]); w.y = pk2(a[2], a[3]); w.z = pk2(b[0], b[1]); w.w = pk2(b[2], b[3]);
                    *(u32x4*)(O + (size_t)(row0 + ai * 128 + m * 16) * ldc + col0 + bj * 128) = w;
                }
    }
};
struct EpiMerge2 {
    static constexpr bool PERM = true, AFTER_DRAIN = false, HAS_MID = true;
    bf16_t* Yo; const bf16_t* P;
    __device__ __forceinline__ void mid(f32x4 (&acc)[2][2][4][2], const Unit& u, int wr, int wc, int fr, int fq) const {
        asm volatile("" : "+v"(fr), "+v"(fq));
        const int row0 = u.pm * 256 + wr * 64 + fr, col0 = u.pn * 256 + wc * 32 + 8 * fq;
#pragma unroll
        for (int ai = 0; ai < 2; ++ai)
#pragma unroll
            for (int m = 0; m < 4; ++m)
#pragma unroll
                for (int bj = 0; bj < 2; ++bj) {
                    const size_t r = (size_t)(row0 + ai * 128 + m * 16); const int c = col0 + bj * 128;
                    const u32x4 ga = *(const u32x4*)(P + r * PW + 2560 + c), gb = *(const u32x4*)(P + r * PW + 3584 + c);
                    const float q0 = bflo(ga.x) * __builtin_amdgcn_rcpf(bflo(gb.x)), q1 = bfhi(ga.x) * __builtin_amdgcn_rcpf(bfhi(gb.x));
                    const float q2 = bflo(ga.y) * __builtin_amdgcn_rcpf(bflo(gb.y)), q3 = bfhi(ga.y) * __builtin_amdgcn_rcpf(bfhi(gb.y));
                    const float q4 = bflo(ga.z) * __builtin_amdgcn_rcpf(bflo(gb.z)), q5 = bfhi(ga.z) * __builtin_amdgcn_rcpf(bfhi(gb.z));
                    const float q6 = bflo(ga.w) * __builtin_amdgcn_rcpf(bflo(gb.w)), q7 = bfhi(ga.w) * __builtin_amdgcn_rcpf(bfhi(gb.w));
                    acc[ai][bj][m][0] *= (f32x4){q0, q1, q2, q3}; acc[ai][bj][m][1] *= (f32x4){q4, q5, q6, q7};
                    asm volatile("" ::: "memory");
                }
    }
    __device__ __forceinline__ void operator()(const f32x4 (&acc)[2][2][4][2], const Unit& u, int wr, int wc, int fr, int fq) const {
        const int row0 = u.pm * 256 + wr * 64 + fr, col0 = u.pn * 256 + wc * 32 + 8 * fq;
#pragma unroll
        for (int ai = 0; ai < 2; ++ai)
#pragma unroll
            for (int m = 0; m < 4; ++m)
#pragma unroll
                for (int bj = 0; bj < 2; ++bj) {
                    const size_t r = (size_t)(row0 + ai * 128 + m * 16); const int c = col0 + bj * 128;
                    const u32x4 g = *(const u32x4*)(P + r * PW + 3584 + c);
                    const f32x4 a = acc[ai][bj][m][0], b = acc[ai][bj][m][1];
                    u32x4 w; w.x = pk2(a[0] * bflo(g.x), a[1] * bfhi(g.x)); w.y = pk2(a[2] * bflo(g.y), a[3] * bfhi(g.y)); w.z = pk2(b[0] * bflo(g.z), b[1] * bfhi(g.z)); w.w = pk2(b[2] * bflo(g.w), b[3] * bfhi(g.w));
                    *(u32x4*)(Yo + r * D + c) = w;
                }
    }
};
struct EpiIn {
    static constexpr bool PERM = true, AFTER_DRAIN = false, HAS_MID = false;
    bf16_t* P; bf16_t* Pc; bf16_t* Qn; bf16_t* Kn; bf16_t* Vt; const float* qg; const float* kg; const float* lb; const float* rope;
    __device__ __forceinline__ void operator()(const f32x4 (&acc)[2][2][4][2], const Unit& u, int wr, int wc, int fr, int fq) const {
        const int pn = u.pn; const bool isctx = u.pm >= 128;
        const int row0 = u.pm * 256 + wr * 64 + fr;
        if (pn <= 2) {
            if (pn == 2 && wc >= 2) {
                const int kvh = wc - 2;
#pragma unroll
                for (int ai = 0; ai < 2; ++ai)
#pragma unroll
                    for (int m = 0; m < 4; ++m) {
                        const int row = row0 + ai * 128 + m * 16;
                        int b, key; if (!isctx) { b = row >> 11; key = row & 2047; } else { const int rc = row - TL; b = rc >> 8; key = SEQ + (rc & 255); }
                        bf16_t* base = Vt + (size_t)((b * 2 + kvh) * 64) * NKEY + key;
#pragma unroll
                        for (int bj = 0; bj < 2; ++bj)
#pragma unroll
                            for (int n = 0; n < 2; ++n)
#pragma unroll
                                for (int j = 0; j < 4; j += 2) {
                                    const unsigned w = pk2(acc[ai][bj][m][n][j], acc[ai][bj][m][n][j + 1]);
                                    const int d = 32 * bj + 8 * fq + 4 * n + j;
                                    base[(size_t)d * NKEY] = (bf16_t)(w & 0xffffu); base[(size_t)(d + 1) * NKEY] = (bf16_t)(w >> 16);
                                }
                    }
            } else {
                const bool isk = (pn == 2);
                const float* gain = isk ? kg : qg;
                float gn[2][8];
#pragma unroll
                for (int bj = 0; bj < 2; ++bj)
#pragma unroll
                    for (int e = 0; e < 8; ++e) gn[bj][e] = gain[32 * bj + 8 * fq + e];
                const float osc = isk ? 1.0f : (0.125f * 1.4426950408889634f);
#pragma unroll
                for (int ai = 0; ai < 2; ++ai)
#pragma unroll
                    for (int m = 0; m < 4; ++m) {
                        const int row = row0 + ai * 128 + m * 16;
                        float y[2][8]; float ss = 0.f;
#pragma unroll
                        for (int bj = 0; bj < 2; ++bj)
#pragma unroll
                            for (int n = 0; n < 2; ++n)
#pragma unroll
                                for (int j = 0; j < 4; ++j) { const float v = acc[ai][bj][m][n][j]; y[bj][n * 4 + j] = v; ss += v * v; }
                        ss += __shfl_xor(ss, 16); ss += __shfl_xor(ss, 32);
                        const float rstd = rsqrtf(ss * (1.0f / 64.0f) + EPS);
#pragma unroll
                        for (int bj = 0; bj < 2; ++bj)
#pragma unroll
                            for (int e = 0; e < 8; ++e) y[bj][e] *= rstd * gn[bj][e];
                        if (!isctx) {
                            const int t = row & 2047;
#pragma unroll
                            for (int bj = 0; bj < 2; ++bj) {
                                const int pos = bj ? (t & 63) : (t >> 6);
                                const float* rp = rope + (pos * 16 + 8 * (fq & 1)) * 2;
#pragma unroll
                                for (int e = 0; e < 8; e += 2) {
                                    const f32x4 cs = *(const f32x4*)(rp + e * 2);
                                    const float p0 = __shfl_xor(y[bj][e], 32), p1 = __shfl_xor(y[bj][e + 1], 32);
                                    const float s0 = (fq >> 1) ? p0 : -p0, s1 = (fq >> 1) ? p1 : -p1;
                                    y[bj][e] = y[bj][e] * cs[0] + s0 * cs[1]; y[bj][e + 1] = y[bj][e + 1] * cs[2] + s1 * cs[3];
                                }
                            }
                        }
                        bf16_t* dst;
                        if (!isk) dst = Qn + (size_t)row * 512 + (4 * pn + wc) * 64 + 8 * fq;
                        else { int b, key; if (!isctx) { b = row >> 11; key = row & 2047; } else { const int rc = row - TL; b = rc >> 8; key = SEQ + (rc & 255); }
                               dst = Kn + ((size_t)(b * 2 + wc) * NKEY + key) * 64 + 8 * fq; }
#pragma unroll
                        for (int bj = 0; bj < 2; ++bj) {
                            u32x4 w; w.x = pk2(y[bj][0] * osc, y[bj][1] * osc); w.y = pk2(y[bj][2] * osc, y[bj][3] * osc); w.z = pk2(y[bj][4] * osc, y[bj][5] * osc); w.w = pk2(y[bj][6] * osc, y[bj][7] * osc);
                            *(u32x4*)(dst + 32 * bj) = w;
                        }
                    }
            }
        } else {
            const int cls = (pn <= 4) ? 0 : (pn <= 6) ? 1 : (pn <= 8) ? 2 : (pn <= 10) ? 3 : (pn <= 12) ? 4 : 5;
#pragma unroll
            for (int bj = 0; bj < 2; ++bj) {
                const int c = pn * 256 + bj * 128 + wc * 32 + 8 * fq;
                float lbv[8];
                if (cls == 2 || cls == 3) {
                    const float* lp = lb + (cls == 3 ? 512 : 0) + (c - (cls == 3 ? 2304 : 1792));
#pragma unroll
                    for (int e = 0; e < 8; ++e) lbv[e] = 1.0f - lp[e];
                }
#pragma unroll
                for (int ai = 0; ai < 2; ++ai)
#pragma unroll
                    for (int m = 0; m < 4; ++m) {
                        const int row = row0 + ai * 128 + m * 16;
                        float v[8];
#pragma unroll
                        for (int n = 0; n < 2; ++n)
#pragma unroll
                            for (int j = 0; j < 4; ++j) v[n * 4 + j] = acc[ai][bj][m][n][j];
                        u32x4 w;
                        if (cls == 0) {
#pragma unroll
                            for (int e = 0; e < 8; ++e) v[e] = siluf_(v[e]) * 0.08838834764831845f; }
                        else if (cls == 4) {
#pragma unroll
                            for (int e = 0; e < 8; ++e) v[e] = siluf_(v[e]); }
                        else if (cls == 5) {
#pragma unroll
                            for (int e = 0; e < 8; ++e) v[e] = sigmoidf_(v[e]); }
                        if (cls == 2 || cls == 3) {
#pragma unroll
                            for (int e = 0; e < 8; ++e) v[e] = lbv[e] * sigmoidf_(-v[e]);
                            w.x = pkh2(v[0], v[1]); w.y = pkh2(v[2], v[3]); w.z = pkh2(v[4], v[5]); w.w = pkh2(v[6], v[7]);
                        } else { w.x = pk2(v[0], v[1]); w.y = pk2(v[2], v[3]); w.z = pk2(v[4], v[5]); w.w = pk2(v[6], v[7]); }
                        if (!isctx) *(u32x4*)(P + (size_t)row * PW + (c - 768)) = w;
                        else *(u32x4*)(Pc + (size_t)(row - TL) * PCW + (c - 1280)) = w;
                    }
            }
        }
    }
};

constexpr int AK_PITCH = 144, AV_PITCH = 136, AK_BYTES = 64 * AK_PITCH, AV_BYTES = 64 * AV_PITCH;
constexpr int ATILE_BYTES = AK_BYTES + AV_BYTES;
#define ATT_TILE(TT_, SC_, SN_) do { \
        const bool own_ = ((TT_) + 2 < NT); const int tl = own_ ? (TT_) + 2 : (TT_) + 2 - NT; \
        const bf16_t* Ks_ = own_ ? Kb : Kbn; const bf16_t* Vs_ = own_ ? Vb : Vbn; \
        const u32x4 kreg = *(const u32x4*)(Ks_ + (size_t)(tl * 64 + srow) * 64 + sch * 8); \
        const u32x4 vreg = *(const u32x4*)(Vs_ + (size_t)srow * NKEY + tl * 64 + sch * 8); \
_Pragma("unroll") \
        for (int kb = 0; kb < 2; ++kb) { \
_Pragma("unroll") \
            for (int i = 0; i < 16; ++i) SN_[kb][i] = 0.f; \
_Pragma("unroll") \
            for (int ks = 0; ks < 4; ++ks) { const bf16x8 a = *(const LAS bf16x8*)(lds + bufn + kroff + 32 * kb * AK_PITCH + 32 * ks); \
                SN_[kb] = __builtin_amdgcn_mfma_f32_32x32x16_bf16(a, qf[ks], SN_[kb], 0, 0, 0); } \
        } \
        f32x2_t m2 = {0.f, 0.f}; \
        if (!BOUNDED) { \
            float mx = SC_[0][0]; \
_Pragma("unroll") \
            for (int i = 1; i < 16; ++i) mx = fmaxf(mx, SC_[0][i]); \
_Pragma("unroll") \
            for (int i = 0; i < 16; ++i) mx = fmaxf(mx, SC_[1][i]); \
            mx = fmaxf(mx, __shfl_xor(mx, 32)); \
            const float mnew = fmaxf(mrun, mx); \
            if (__any(mnew > mrun)) { \
                const float alpha = __builtin_amdgcn_exp2f(mrun - mnew); \
                lrun *= alpha; \
_Pragma("unroll") \
                for (int i = 0; i < 16; ++i) { o[0][i] *= alpha; o[1][i] *= alpha; } \
            } \
            mrun = mnew; \
            m2 = (f32x2_t){mnew, mnew}; \
        } \
        float psx = 0.f, psy = 0.f; \
        u32x4 pw[2][2]; \
_Pragma("unroll") \
        for (int kb = 0; kb < 2; ++kb) \
_Pragma("unroll") \
            for (int ks = 0; ks < 2; ++ks) { \
                unsigned w4[4]; \
_Pragma("unroll") \
                for (int j2 = 0; j2 < 4; ++j2) { \
                    f32x2_t v = (f32x2_t){SC_[kb][8 * ks + 2 * j2], SC_[kb][8 * ks + 2 * j2 + 1]}; \
                    if (!BOUNDED) v -= m2; \
                    v.x = __builtin_amdgcn_exp2f(v.x); v.y = __builtin_amdgcn_exp2f(v.y); \
                    psx += v.x; psy += v.y; w4[j2] = pk2(v.x, v.y); \
                } \
                pw[kb][ks] = (u32x4){w4[0], w4[1], w4[2], w4[3]}; \
            } \
        lrun += psx + psy; \
_Pragma("unroll") \
        for (int kb = 0; kb < 2; ++kb) \
_Pragma("unroll") \
            for (int ks = 0; ks < 2; ++ks) { \
                const bf16x8 pf = __builtin_bit_cast(bf16x8, pw[kb][ks]); \
_Pragma("unroll") \
                for (int db = 0; db < 2; ++db) { \
                    LAS unsigned char* vp = lds + bufc + vroff + 32 * db * AV_PITCH + (32 * kb + 16 * ks) * 2; \
                    const u32x2 lo = *(const LAS u32x2*)vp, hi = *(const LAS u32x2*)(vp + 16); \
                    const bf16x8 a = __builtin_bit_cast(bf16x8, (u32x4){lo.x, lo.y, hi.x, hi.y}); \
                    o[db] = __builtin_amdgcn_mfma_f32_32x32x16_bf16(a, pf, o[db], 0, 0, 0); \
                } \
            } \
        *(LAS u32x4*)(lds + bufw + kwoff) = kreg; \
        { LAS u32x2* vp = (LAS u32x2*)(lds + bufw + vwoff); vp[0] = (u32x2){vreg.x, vreg.y}; vp[1] = (u32x2){vreg.z, vreg.w}; } \
        __syncthreads(); \
        { const int tmp = bufc; bufc = bufn; bufn = bufw; bufw = tmp; } \
    } while (0)
template <bool BOUNDED>
__device__ __forceinline__ void attn_phase(unsigned* ctl, const bf16_t* __restrict__ Kn, const bf16_t* __restrict__ Vt, const bf16_t* __restrict__ QO, bf16_t* __restrict__ OM, LAS unsigned char* lds) {
    volatile LAS unsigned* bc = (volatile LAS unsigned*)(lds + MISC_OFF);
    const int tid = opaque_tid(), wave = tid >> 6, lane = tid & 63, r32 = lane & 31, hh = lane >> 5;
    const int srow = tid >> 3, sch = tid & 7;
    const int kwoff = srow * AK_PITCH + sch * 16, vwoff = AK_BYTES + srow * AV_PITCH + sch * 16;
    const int kroff = r32 * AK_PITCH + 16 * hh, vroff = AK_BYTES + r32 * AV_PITCH + 8 * hh;
    constexpr int NT = NKEY / 64;
    __syncthreads();
    if (tid == 0) bc[0] = atomicAdd(ctl, 1u);
    __syncthreads();
    unsigned cur = bc[0];
    if (cur >= 1024u) return;
    bf16x8 qf[4];
    {
        const int g = cur & 3, qb = (cur >> 2) & 7, bk = cur >> 5, b = bk >> 1, kvh = bk & 1, h = kvh * 4 + g;
        const size_t tok = (size_t)b * SEQ + qb * 256 + wave * 32 + r32;
#pragma unroll
        for (int s = 0; s < 4; ++s) qf[s] = *(const bf16x8*)(QO + tok * 512 + h * 64 + 16 * s + 8 * hh);
        const bf16_t* Kb = Kn + (size_t)bk * NKEY * 64; const bf16_t* Vb = Vt + (size_t)bk * 64 * NKEY;
#pragma unroll
        for (int sb = 0; sb < 2; ++sb) {
            const u32x4 kr = *(const u32x4*)(Kb + (size_t)(sb * 64 + srow) * 64 + sch * 8);
            const u32x4 vr = *(const u32x4*)(Vb + (size_t)srow * NKEY + sb * 64 + sch * 8);
            *(LAS u32x4*)(lds + sb * ATILE_BYTES + kwoff) = kr;
            LAS u32x2* vp = (LAS u32x2*)(lds + sb * ATILE_BYTES + vwoff); vp[0] = (u32x2){vr.x, vr.y}; vp[1] = (u32x2){vr.z, vr.w};
        }
    }
    __syncthreads();
    int bufc = 0, bufn = ATILE_BYTES, bufw = 2 * ATILE_BYTES;
    int par = 1;
    for (;;) {
        const int g = cur & 3, qb = (cur >> 2) & 7, bk = cur >> 5, b = bk >> 1, kvh = bk & 1, h = kvh * 4 + g;
        const size_t tok = (size_t)b * SEQ + qb * 256 + wave * 32 + r32;
        const bf16_t* Kb = Kn + (size_t)bk * NKEY * 64; const bf16_t* Vb = Vt + (size_t)bk * 64 * NKEY;
        const bf16_t* Kbn = Kb; const bf16_t* Vbn = Vb;
        unsigned nxt = 0xffffffffu;
        bf16x8 qn[4];
#pragma unroll
        for (int s = 0; s < 4; ++s) qn[s] = qf[s];
        f32x16 o[2];
#pragma unroll
        for (int i = 0; i < 16; ++i) { o[0][i] = 0.f; o[1][i] = 0.f; }
        float mrun = -1e30f, lrun = 0.f;
        f32x16 sc[2];
#pragma unroll
        for (int kb = 0; kb < 2; ++kb) {
#pragma unroll
            for (int i = 0; i < 16; ++i) sc[kb][i] = 0.f;
#pragma unroll
            for (int ks = 0; ks < 4; ++ks) { const bf16x8 a = *(const LAS bf16x8*)(lds + bufc + kroff + 32 * kb * AK_PITCH + 32 * ks);
                sc[kb] = __builtin_amdgcn_mfma_f32_32x32x16_bf16(a, qf[ks], sc[kb], 0, 0, 0); }
        }
        f32x16 sd[2];
        for (int t = 0; t < NT; t += 2) {
            if (t == NT - 8) { if (tid == 0) bc[par] = atomicAdd(ctl, 1u); }
            if (t == NT - 4) {
                nxt = bc[par];
                if (nxt < 1024u) {
                    const int gn = nxt & 3, qbn = (nxt >> 2) & 7, bkn = nxt >> 5, bn = bkn >> 1, hn = (bkn & 1) * 4 + gn;
                    Kbn = Kn + (size_t)bkn * NKEY * 64; Vbn = Vt + (size_t)bkn * 64 * NKEY;
                    const size_t tokn = (size_t)bn * SEQ + qbn * 256 + wave * 32 + r32;
#pragma unroll
                    for (int s = 0; s < 4; ++s) qn[s] = *(const bf16x8*)(QO + tokn * 512 + hn * 64 + 16 * s + 8 * hh);
                }
            }
            ATT_TILE(t, sc, sd);
            ATT_TILE(t + 1, sd, sc);
        }
        const float l = lrun + __shfl_xor(lrun, 32); const float inv = 1.0f / l;
#pragma unroll
        for (int db = 0; db < 2; ++db)
#pragma unroll
            for (int g4 = 0; g4 < 4; ++g4) {
                u32x2 w; w.x = pk2(o[db][4 * g4] * inv, o[db][4 * g4 + 1] * inv); w.y = pk2(o[db][4 * g4 + 2] * inv, o[db][4 * g4 + 3] * inv);
                *(u32x2*)(OM + tok * 1024 + h * 64 + 32 * db + 8 * g4 + 4 * hh) = w;
            }
        if (nxt >= 1024u) break;
        cur = nxt; par ^= 1;
#pragma unroll
        for (int s = 0; s < 4; ++s) qf[s] = qn[s];
    }
}

constexpr int HG_IMG = 67584, HG_QH = 0, HG_KB = 17408, HG_KT = 34816, HG_VT = 51200;
constexpr int HG_AI = 2 * HG_IMG, HG_TOT = HG_AI + 9216, HG_EL = HG_TOT + 8192;
constexpr int HG_END = HG_EL + 1024;
constexpr int HP = 272;
__device__ __forceinline__ int swz128(int row, int s) { return row * 128 + (((((s >> 3) ^ (row >> 3) ^ (row >> 1)) & 7)) << 4) + (s & 7) * 2; }
#define HG_LOAD(NC) do { const int n_ = (NC); const bool ic_ = n_ < 4; const int nn_ = ic_ ? n_ : n_ - 4; \
        _Pragma("unroll") for (int st = 0; st < 4; ++st) { const int pos = 64 * nn_ + 4 * sg + st; \
            if (ic_) { const int tk = dir ? (CTXL - 1 - pos) : pos; const bf16_t* rp = Pc + (size_t)(b * CTXL + tk) * PCW; \
                kraw[st] = *(const u32x2*)(rp + 512 + dir * 512 + head * 128 + 4 * cgi); qraw[st] = (u32x2){0u, 0u}; } \
            else { const int tk = dir ? (SEQ - 1 - pos) : pos; const bf16_t* rp = P + (size_t)(b * SEQ + tk) * PW; \
                kraw[st] = *(const u32x2*)(rp + 1024 + dir * 512 + head * 128 + 4 * cgi); qraw[st] = *(const u32x2*)(rp + head * 128 + 4 * cgi); } } \
        _Pragma("unroll") for (int e = 0; e < 2; ++e) { const int pos = 64 * nn_ + 2 * sp + e; \
            if (ic_) { const int tk = dir ? (CTXL - 1 - pos) : pos; vraw[e] = *(const u32x4*)(Pc + (size_t)(b * CTXL + tk) * PCW + head * 128 + 8 * vg); } \
            else { const int tk = dir ? (SEQ - 1 - pos) : pos; vraw[e] = *(const u32x4*)(P + (size_t)(b * SEQ + tk) * PW + 512 + head * 128 + 8 * vg); } } } while (0)
#define HG_PREP_A() do { \
        _Pragma("unroll") for (int st = 0; st < 4; ++st) { \
            kv[st] = (f32x4){hlo(kraw[st].x), hhi(kraw[st].x), hlo(kraw[st].y), hhi(kraw[st].y)}; \
            const f32x4 f_ = 1.0f - kv[st]; \
            El[st] = (st == 0) ? f_ : El[st - 1] * f_; } \
        *(LAS f32x4*)(lds + HG_TOT + (sg * 128 + 4 * cgi) * 4) = El[3]; } while (0)
#define HG_PREP_B(PCTX, IB, ES) do { \
        f32x4 pre = (f32x4){1.f, 1.f, 1.f, 1.f}, mypre = pre; \
        _Pragma("unroll") for (int s2 = 0; s2 < 16; ++s2) { \
            const f32x4 tv = *(const LAS f32x4*)(lds + HG_TOT + (s2 * 128 + 4 * cgi) * 4); \
            if (s2 == sg) mypre = pre; \
            pre *= tv; } \
        const f32x4 elast = pre; \
        f32x4 kh[4], Rv[4]; \
        { const f32x4 E3 = mypre * El[3]; \
          Rv[3][0] = __builtin_amdgcn_rcpf(E3[0]); Rv[3][1] = __builtin_amdgcn_rcpf(E3[1]); Rv[3][2] = __builtin_amdgcn_rcpf(E3[2]); Rv[3][3] = __builtin_amdgcn_rcpf(E3[3]); \
          Rv[2] = Rv[3] * (1.0f - kv[3]); Rv[1] = Rv[2] * (1.0f - kv[2]); Rv[0] = Rv[1] * (1.0f - kv[1]); } \
        _Pragma("unroll") for (int st = 0; st < 4; ++st) { \
            const f32x4 E = mypre * El[st]; \
            const f32x4 kr = kv[st] * Rv[st]; \
            kh[st] = kr * elast; \
            if (!(PCTX)) { \
                const f32x4 qv = (f32x4){bflo(qraw[st].x), bfhi(qraw[st].x), bflo(qraw[st].y), bfhi(qraw[st].y)}; \
                const f32x4 qe = qv * E; \
                const int off = (4 * sg + st) * HP + 8 * cgi; \
                *(LAS u32x2*)(lds + (IB) + HG_QH + off) = (u32x2){pk2(qe[0], qe[1]), pk2(qe[2], qe[3])}; \
                *(LAS u32x2*)(lds + (IB) + HG_KB + off) = (u32x2){pk2(kr[0], kr[1]), pk2(kr[2], kr[3])}; } } \
        _Pragma("unroll") for (int i = 0; i < 4; ++i) { \
            const int ch = 4 * cgi + i; \
            *(LAS u32x2*)(lds + (IB) + HG_KT + swz128(ch, 4 * sg)) = (u32x2){pk2(kh[0][i], kh[1][i]), pk2(kh[2][i], kh[3][i])}; } \
        if (sg == 0) *(LAS f32x4*)(lds + HG_EL + (ES) * 512 + 16 * cgi) = elast; \
        { const unsigned a_[4] = {vraw[0].x, vraw[0].y, vraw[0].z, vraw[0].w}, c2_[4] = {vraw[1].x, vraw[1].y, vraw[1].z, vraw[1].w}; \
          _Pragma("unroll") for (int i = 0; i < 4; ++i) { \
              const unsigned lo = (a_[i] & 0xffffu) | (c2_[i] << 16), hi = (a_[i] >> 16) | (c2_[i] & 0xffff0000u); \
              *(LAS unsigned*)(lds + (IB) + HG_VT + swz128(8 * vg + 2 * i, 2 * sp)) = lo; \
              *(LAS unsigned*)(lds + (IB) + HG_VT + swz128(8 * vg + 2 * i + 1, 2 * sp)) = hi; } } } while (0)
__device__ __forceinline__ void hgrn_item(int item, const bf16_t* __restrict__ P, const bf16_t* __restrict__ Pc, bf16_t* __restrict__ OHF, bf16_t* __restrict__ OHB, LAS unsigned char* lds) {
    const int dir = item & 1, head = (item >> 1) & 3, b = item >> 3;
    const int tid = opaque_tid(), w = tid >> 6, lane = tid & 63, l15 = lane & 15, q4 = lane >> 4;
    const int cgi = tid & 31, sg = tid >> 5;
    const int sp = tid >> 4, vg = tid & 15;
    bf16_t* Oout = dir ? OHB : OHF;
    f32x4 S[8];
#pragma unroll
    for (int i = 0; i < 8; ++i) S[i] = (f32x4){0.f, 0.f, 0.f, 0.f};
    u32x2 kraw[4], qraw[4]; u32x4 vraw[2];
    f32x4 kv[4], El[4];
    HG_LOAD(0);
    HG_PREP_A();
    __syncthreads();
    HG_PREP_B(true, 0, 0);
    HG_LOAD(1);
    __syncthreads();
    for (int n = 0; n < 36; ++n) {
        const bool isctx = n < 4; const int nn = isctx ? n : n - 4;
        const int cbuf = (n & 1) * HG_IMG, nbuf = HG_IMG - cbuf;
        const bool has_next = n + 1 < 36;
        if (has_next) HG_PREP_A();
        f32x4 O[4];
#pragma unroll
        for (int i = 0; i < 4; ++i) O[i] = (f32x4){0.f, 0.f, 0.f, 0.f};
        if (!isctx) {
#pragma unroll
            for (int tt = 0; tt < 2; ++tt) {
                const int tl = 2 * w + tt, st_ = tl >> 2, ct = tl & 3;
                f32x4 c4 = (f32x4){0.f, 0.f, 0.f, 0.f};
                if (st_ <= ct) {
#pragma unroll
                    for (int ks = 0; ks < 4; ++ks) {
                        const bf16x8 a = *(const LAS bf16x8*)(lds + cbuf + HG_KB + (16 * st_ + l15) * HP + (32 * ks + 8 * q4) * 2);
                        const bf16x8 bb = *(const LAS bf16x8*)(lds + cbuf + HG_QH + (16 * ct + l15) * HP + (32 * ks + 8 * q4) * 2);
                        c4 = __builtin_amdgcn_mfma_f32_16x16x32_bf16(a, bb, c4, 0, 0, 0);
                    }
                    const int cc = 16 * ct + l15, s0 = 16 * st_ + 4 * q4;
#pragma unroll
                    for (int j = 0; j < 4; ++j) if (s0 + j > cc) c4[j] = 0.f;
                }
                *(LAS u32x2*)(lds + HG_AI + (16 * ct + l15) * 144 + (16 * st_ + 4 * q4) * 2) = (u32x2){pk2(c4[0], c4[1]), pk2(c4[2], c4[3])};
            }
#pragma unroll
            for (int ks = 0; ks < 4; ++ks) {
                const f32x4 s0 = S[2 * ks], s1 = S[2 * ks + 1];
                const bf16x8 a = __builtin_bit_cast(bf16x8, (u32x4){pk2(s0[0], s0[1]), pk2(s0[2], s0[3]), pk2(s1[0], s1[1]), pk2(s1[2], s1[3])});
#pragma unroll
                for (int ct = 0; ct < 4; ++ct) {
                    LAS unsigned char* qp = lds + cbuf + HG_QH + (16 * ct + l15) * HP + (32 * ks + 4 * q4) * 2;
                    const u32x2 lo = *(const LAS u32x2*)qp, hi = *(const LAS u32x2*)(qp + 32);
                    const bf16x8 bb = __builtin_bit_cast(bf16x8, (u32x4){lo.x, lo.y, hi.x, hi.y});
                    O[ct] = __builtin_amdgcn_mfma_f32_16x16x32_bf16(a, bb, O[ct], 0, 0, 0);
                }
            }
        }
        __syncthreads();
        if (has_next) { if (n + 1 < 4) HG_PREP_B(true, nbuf, (n + 1) & 1); else HG_PREP_B(false, nbuf, (n + 1) & 1);
            if (n + 2 < 36) HG_LOAD(n + 2); }
        if (!isctx) {
#pragma unroll
            for (int ks = 0; ks < 2; ++ks) {
                const bf16x8 a = *(const LAS bf16x8*)(lds + cbuf + HG_VT + swz128(16 * w + l15, 32 * ks + 8 * q4));
#pragma unroll
                for (int ct = 0; ct < 4; ++ct) {
                    const bf16x8 bb = *(const LAS bf16x8*)(lds + HG_AI + (16 * ct + l15) * 144 + (32 * ks + 8 * q4) * 2);
                    O[ct] = __builtin_amdgcn_mfma_f32_16x16x32_bf16(a, bb, O[ct], 0, 0, 0);
                }
            }
#pragma unroll
            for (int ct = 0; ct < 4; ++ct) {
                const int pos = 64 * nn + 16 * ct + l15; const int tk = dir ? (SEQ - 1 - pos) : pos;
                *(u32x2*)(Oout + (size_t)(b * SEQ + tk) * 512 + head * 128 + 16 * w + 4 * q4) = (u32x2){pk2(O[ct][0], O[ct][1]), pk2(O[ct][2], O[ct][3])};
            }
        }
        {
            bf16x8 vb2[2];
#pragma unroll
            for (int ks = 0; ks < 2; ++ks) vb2[ks] = *(const LAS bf16x8*)(lds + cbuf + HG_VT + swz128(16 * w + l15, 32 * ks + 8 * q4));
#pragma unroll
            for (int cht = 0; cht < 8; ++cht) {
                const f32x4 el = *(const LAS f32x4*)(lds + HG_EL + (n & 1) * 512 + (16 * cht + 4 * q4) * 4);
                S[cht] *= el;
#pragma unroll
                for (int ks = 0; ks < 2; ++ks) {
                    const bf16x8 a = *(const LAS bf16x8*)(lds + cbuf + HG_KT + swz128(16 * cht + l15, 32 * ks + 8 * q4));
                    S[cht] = __builtin_amdgcn_mfma_f32_16x16x32_bf16(a, vb2[ks], S[cht], 0, 0, 0);
                }
            }
        }
        __syncthreads();
    }
}

__device__ __forceinline__ void hg_out_pass(const bf16_t* __restrict__ OHF, const bf16_t* __restrict__ OHB, const bf16_t* __restrict__ P, const float* __restrict__ hgain, bf16_t* __restrict__ OM) {
    const int tid_ = opaque_tid(); const int lane = tid_ & 63, wave = tid_ >> 6;
    float gn[8];
#pragma unroll
    for (int e = 0; e < 8; ++e) gn[e] = hgain[(lane & 15) * 8 + e];
    const int W = (int)gridDim.x * 8, gw = (int)blockIdx.x * 8 + wave;
    const int rpw = (TL + W - 1) / W;
    const int r0 = gw * rpw, r1 = (r0 + rpw < TL) ? r0 + rpw : TL;
    if (r0 < r1) {
        u32x4 a = *(const u32x4*)(OHF + (size_t)r0 * 512 + lane * 8), c = *(const u32x4*)(OHB + (size_t)r0 * 512 + lane * 8), gt = *(const u32x4*)(P + (size_t)r0 * PW + 2048 + lane * 8);
        for (int r = r0; r < r1; ++r) {
            u32x4 an = a, cn = c, gtn = gt;
            if (r + 1 < r1) { an = *(const u32x4*)(OHF + (size_t)(r + 1) * 512 + lane * 8); cn = *(const u32x4*)(OHB + (size_t)(r + 1) * 512 + lane * 8); gtn = *(const u32x4*)(P + (size_t)(r + 1) * PW + 2048 + lane * 8); }
            float v[8] = {bflo(a.x) + bflo(c.x), bfhi(a.x) + bfhi(c.x), bflo(a.y) + bflo(c.y), bfhi(a.y) + bfhi(c.y), bflo(a.z) + bflo(c.z), bfhi(a.z) + bfhi(c.z), bflo(a.w) + bflo(c.w), bfhi(a.w) + bfhi(c.w)};
            float ss = 0.f;
#pragma unroll
            for (int e = 0; e < 8; ++e) ss += v[e] * v[e];
            ss += __shfl_xor(ss, 1); ss += __shfl_xor(ss, 2); ss += __shfl_xor(ss, 4); ss += __shfl_xor(ss, 8);
            const float rstd = rsqrtf(ss * (1.0f / 128.0f) + EPS);
            const float gg[8] = {bflo(gt.x), bfhi(gt.x), bflo(gt.y), bfhi(gt.y), bflo(gt.z), bfhi(gt.z), bflo(gt.w), bfhi(gt.w)};
#pragma unroll
            for (int e = 0; e < 8; ++e) v[e] = v[e] * rstd * gn[e] * gg[e];
            u32x4 wv; wv.x = pk2(v[0], v[1]); wv.y = pk2(v[2], v[3]); wv.z = pk2(v[4], v[5]); wv.w = pk2(v[6], v[7]);
            *(u32x4*)(OM + (size_t)r * 1024 + 512 + lane * 8) = wv;
            a = an; c = cn; gt = gtn;
        }
    }
}

#define XB_TMO      128
#define XB_XCNT(j)  (256  + 64 * (j))
#define XB_XCNT(j)  (256  + 64 * (j))
#define XB_XSUB(j)  (1280 + 64 * (j))
#define XB_XGEN(j)  (2304 + 64 * (j))
#define XB_TOP      3328
#define XB_TOPGEN   3392
#define XCD_BAR_WORDS 3456
#define XB_SPIN_CAP (1u << 18)

__device__ __forceinline__ unsigned xb_ld(unsigned* p)              { return __hip_atomic_load(p, __ATOMIC_RELAXED, __HIP_MEMORY_SCOPE_AGENT); }
__device__ __forceinline__ unsigned xb_add(unsigned* p, unsigned v) { return __hip_atomic_fetch_add(p, v, __ATOMIC_RELAXED, __HIP_MEMORY_SCOPE_AGENT); }
__device__ __forceinline__ unsigned xb_xcc_id() { return (unsigned)__builtin_amdgcn_s_getreg((3 << 11) | 20) & 0xFu; }
#define XB_SPIN(cond, bar) do { unsigned _sp = 0; while (cond) { __builtin_amdgcn_s_sleep(1); \
    if ((++_sp & 255u) == 0u) { if (xb_ld(&(bar)[XB_TMO])) break; if (_sp > XB_SPIN_CAP) { atomicAdd(&(bar)[XB_TMO], 1u); break; } } } } while (0)

struct XcdBarrier {
    unsigned* bar; unsigned x;
    volatile LAS unsigned* st;
};

__device__ __forceinline__ XcdBarrier xcd_barrier_post(unsigned* bar, volatile LAS unsigned* st) {
    XcdBarrier b; b.bar = bar; b.x = xb_xcc_id(); b.st = st;
    if (threadIdx.x == 0) (void)xb_add(&bar[XB_XCNT(b.x)], 1u);
    return b;
}
__device__ __forceinline__ void xcd_barrier_complete(unsigned* bar, unsigned x, unsigned& nloc, unsigned& nx) {
    const unsigned G = gridDim.x * gridDim.y * gridDim.z;
    unsigned sum, cnt, mine, sp = 0u;
    for (;;) {
        sum = 0u; cnt = 0u; mine = 0u;
#pragma unroll
        for (unsigned j = 0; j < 16; ++j) { const unsigned c = xb_ld(&bar[XB_XCNT(j)]); sum += c; cnt += (c > 0u) ? 1u : 0u; mine = (j == x) ? c : mine; }
        if (sum == G) break;
        __builtin_amdgcn_s_sleep(1);
        if ((++sp & 255u) == 0u) { if (xb_ld(&bar[XB_TMO])) break; if (sp > XB_SPIN_CAP) { atomicAdd(&bar[XB_TMO], 1u); break; } }
    }
    nloc = mine > 0u ? mine : 1u; nx = cnt > 0u ? cnt : 1u;
}

__device__ __forceinline__ void xcd_barrier(const XcdBarrier& b) {
    asm volatile("s_waitcnt vmcnt(0)" ::: "memory");
    __syncthreads();
    if (threadIdx.x == 0) {
        unsigned* bar = b.bar;
        __builtin_amdgcn_s_waitcnt(0);
        unsigned nloc = b.st[0], nx = b.st[1];
        if (nloc == 0u) { xcd_barrier_complete(bar, b.x, nloc, nx); b.st[0] = nloc; b.st[1] = nx; }
        const unsigned old = xb_add(&bar[XB_XSUB(b.x)], 1u);
        const unsigned gen = old / nloc;
        if (old + 1u == (gen + 1u) * nloc) {
            __builtin_amdgcn_fence(__ATOMIC_RELEASE, "agent");
            asm volatile("s_waitcnt vmcnt(0)" ::: "memory");
            const unsigned og = xb_add(&bar[XB_TOP], 1u);
            const unsigned tg = og / nx;
            if (og + 1u == (tg + 1u) * nx) xb_add(&bar[XB_TOPGEN], 1u);
            else XB_SPIN(xb_ld(&bar[XB_TOPGEN]) == tg, bar);
            __builtin_amdgcn_fence(__ATOMIC_ACQUIRE, "agent");
            xb_add(&bar[XB_XGEN(b.x)], 1u);
            asm volatile("s_waitcnt vmcnt(0)" ::: "memory");
        } else {
            XB_SPIN(xb_ld(&bar[XB_XGEN(b.x)]) == gen, bar);
            __builtin_amdgcn_fence(__ATOMIC_ACQUIRE, "agent");
            asm volatile("s_waitcnt vmcnt(0)" ::: "memory");
        }
    }
    __syncthreads();
}


#define grid_sync_all(gb) xcd_barrier(gb)

__global__ void __launch_bounds__(NTHREADS, 2) fwd_megakernel(Params p) {
    extern __shared__ __attribute__((aligned(16))) unsigned char lds_raw[];
    LAS unsigned char* lds = (LAS unsigned char*)lds_raw;
    cg::grid_group grid = cg::this_grid();
    { volatile LAS unsigned* st0 = (volatile LAS unsigned*)(lds + MISC_OFF + 32); if (threadIdx.x < 2) st0[threadIdx.x] = 0u; }
    __syncthreads();
    XcdBarrier gb = xcd_barrier_post((unsigned*)(p.ws + WS_CTL + 1024), (volatile LAS unsigned*)(lds + MISC_OFF + 32));
    const int G = (int)gridDim.x, bx = (int)blockIdx.x;
    unsigned char* ws = p.ws;
    const float* x = p.in[0]; const float* ctx = p.in[2];
    const float* npre = p.in[6]; const float* npost = p.in[7];
    float* mod = (float*)(ws + WS_MOD);
    bf16_t* U = (bf16_t*)(ws + WS_U); bf16_t* H = (bf16_t*)(ws + WS_BIG); bf16_t* Y = (bf16_t*)(ws + WS_Y); bf16_t* P = (bf16_t*)(ws + WS_BIG);
    bf16_t* Pc = (bf16_t*)(ws + WS_FW); bf16_t* QO = (bf16_t*)(ws + WS_Q); bf16_t* Kn = (bf16_t*)(ws + WS_K); bf16_t* Vt = (bf16_t*)(ws + WS_VT);
    bf16_t* OHF = (bf16_t*)(ws + WS_OHF); bf16_t* OHB = (bf16_t*)(ws + WS_OHB);
    bf16_t* X1B = (bf16_t*)p.out;
    bf16_t* X2B = OHF;
    bf16_t* OM = U;
    bf16_t* YB = OHF;
    float* out = p.out;

    p0_prep(p, lds);
    asm volatile("s_waitcnt vmcnt(0) lgkmcnt(0)" ::: "memory");
    grid.sync();
    if (threadIdx.x < 64) { __builtin_amdgcn_fence(__ATOMIC_ACQUIRE, "agent"); asm volatile("s_waitcnt vmcnt(0)" ::: "memory"); }
    __syncthreads();
    norm_pass(nullptr, x, ctx, nullptr, mod, nullptr, 0, 0.f, nullptr, nullptr, npre + 0 * D, 0, 1, U, TT);
    grid_sync_all(gb);
    { pg8::Gemm g{U, (const bf16_t*)(ws + WS_FW), TT, 2 * DFF, D}; pg8::StaticOrder S; S.init(TT, 2 * DFF, G, bx);
      EpiSwiGLU E{H}; pg8::gemm_phase<EpiSwiGLU, pg8::StaticOrder, true, true>(lds, g, S, E); }
    grid_sync_all(gb);
    { pg8::Gemm g{H, (const bf16_t*)(ws + WS_FW + 11534336), TT, D, DFF}; pg8::StaticOrder S; S.init(TT, D, G, bx);
      EpiStore E{Y, D}; pg8::gemm_phase<EpiStore, pg8::StaticOrder, true, true>(lds, g, S, E); }
    grid_sync_all(gb);
    norm_pass(Y, x, ctx, nullptr, mod, npost + 0 * D, 2, 0.5f, nullptr, X1B, npre + 1 * D, 3, 4, U, TT);
    grid_sync_all(gb);
    { pg8::Gemm g{U, (const bf16_t*)(ws + WS_WIN), TT, DIN, D}; InOrder S; S.init(G, bx);
      EpiIn E{P, Pc, QO, Kn, Vt, p.in[12], p.in[13], (const float*)(ws + WS_LB), (const float*)(ws + WS_ROPE)};
      pg8::gemm_phase<EpiIn, InOrder, true, true>(lds, g, S, E); }
    grid_sync_all(gb);
    {
        for (int it = bx; it < 128; it += G) hgrn_item(it, P, Pc, OHF, OHB, lds);
        unsigned* ctl = (unsigned*)(ws + WS_CTL);
        const float att_cb = ((const float*)(ws + WS_ROPE))[2048]; const bool att_bounded = att_cb <= 30.0f;
        if (att_bounded) attn_phase<true>(ctl, Kn, Vt, QO, OM, lds); else attn_phase<false>(ctl, Kn, Vt, QO, OM, lds);
    }
    grid_sync_all(gb);
    hg_out_pass(OHF, OHB, P, p.in[15], OM);
    grid_sync_all(gb);
    { pg8::Gemm g{OM, (const bf16_t*)(ws + WS_WAO), TL, D, D}; pg8::StaticOrder S; S.init(TL, D, G, bx);
      EpiMerge2 E{YB, P}; pg8::gemm_phase<EpiMerge2, pg8::StaticOrder, true, true>(lds, g, S, E); }
    grid_sync_all(gb);
    { pg8::Gemm g{YB, (const bf16_t*)(ws + WS_WO), TL, D, D}; pg8::StaticOrder S; S.init(TL, D, G, bx);
      EpiStore E{Y, D}; pg8::gemm_phase<EpiStore, pg8::StaticOrder, true, true>(lds, g, S, E); }
    transpose_jobs(p, 1, 3, (LAS float*)lds);
    grid_sync_all(gb);
    norm_pass(Y, nullptr, nullptr, X1B, mod, npost + 1 * D, 5, 1.0f, nullptr, X2B, npre + 2 * D, 6, 7, U, TL);
    grid_sync_all(gb);
    { pg8::Gemm g{U, (const bf16_t*)(ws + WS_Q), TL, 2 * DFF, D}; pg8::StaticOrder S; S.init(TL, 2 * DFF, G, bx);
      EpiSwiGLU E{H}; pg8::gemm_phase<EpiSwiGLU, pg8::StaticOrder, true, true>(lds, g, S, E); }
    grid_sync_all(gb);
    { pg8::Gemm g{H, (const bf16_t*)(ws + WS_Q + 11534336), TL, D, DFF}; pg8::StaticOrder S; S.init(TL, D, G, bx);
      EpiStore E{Y, D}; pg8::gemm_phase<EpiStore, pg8::StaticOrder, true, true>(lds, g, S, E); }
    grid_sync_all(gb);
    norm_pass(Y, nullptr, nullptr, X2B, mod, npost + 2 * D, 8, 0.5f, out, nullptr, nullptr, 0, 0, nullptr, TL);
}

extern "C" void kernel_launch(void* const* d_in, const int* in_sizes, int n_in, void* d_out, int out_size, void* d_ws, size_t ws_size, hipStream_t stream) {
    static int grid_blocks = 0;
    if (grid_blocks == 0) {
        int dev = 0, cus = 0, per_cu = 0;
        hipGetDevice(&dev);
        hipDeviceGetAttribute(&cus, hipDeviceAttributeMultiprocessorCount, dev);
        hipFuncSetAttribute((const void*)fwd_megakernel, hipFuncAttributeMaxDynamicSharedMemorySize, LDS_BYTES);
        hipOccupancyMaxActiveBlocksPerMultiprocessor(&per_cu, (const void*)fwd_megakernel, NTHREADS, LDS_BYTES);
        if (per_cu < 1) per_cu = 1;
        if (per_cu > 1) per_cu = 1;
        grid_blocks = cus * per_cu;
        if (ws_size < WS_END) fprintf(stderr, "kernel_launch: workspace too small: %zu < %zu\n", ws_size, (size_t)WS_END);
        (void)hipGetLastError();
    }
    (void)hipMemsetAsync((unsigned char*)d_ws + WS_CTL, 0, 16384, stream);
    Params p{};
    for (int i = 0; i < 19; ++i) p.in[i] = (const float*)d_in[i];
    p.out = (float*)d_out; p.ws = (unsigned char*)d_ws;
    void* args[] = {&p};
    hipError_t e = hipLaunchCooperativeKernel((const void*)fwd_megakernel, dim3(grid_blocks), dim3(NTHREADS), args, LDS_BYTES, stream);
    if (e != hipSuccess) fprintf(stderr, "cooperative launch failed: %s (grid %d)\n", hipGetErrorString(e), grid_blocks);
}
```
